# Optimizing an MI355X kernel written in HIP

```python
import math
import jax, jax.numpy as jnp
from jax import lax
import numpy as np

D_MODEL = 1024
BATCH = 16
SEQ = 2048
DEPTH = 2

N_MEM = 256
EPS = 1e-6
ROPE_THETA = 10000.0
Q_BLOCK = 128

HY_CH = D_MODEL // 2
HY_ORDER = 2
HY_EMB = 33
HY_BANDS = (HY_EMB - 1) // 2
HY_FFN = 64
HY_FAST_PCT = 0.3
HY_SLOW_PCT = 1.5
HY_TARGET = 1e-2

MLA_HEADS = 8
MLA_NOPE = 64
MLA_ROPE = 32
MLA_V = 64
MLA_QK = MLA_NOPE + MLA_ROPE
MLA_Q_RANK = D_MODEL // 4
MLA_KV_RANK = D_MODEL // 8

IN_EVEN = (HY_ORDER + 1) * HY_CH + MLA_Q_RANK + MLA_KV_RANK + MLA_ROPE
MIX_EVEN = HY_CH + MLA_HEADS * MLA_V

DIFF_HEADS = 8
DIFF_HD = D_MODEL // DIFF_HEADS // 2
SUBLN_EPS = 1e-5

X_HEADS = 4
X_HD = D_MODEL // X_HEADS

D_FF = 4 * D_MODEL

N_EVEN = (DEPTH + 1) // 2
N_ODD = DEPTH // 2

kernel_name = "hybrid_hyena_mla_diffattn_encoder"


def rms_norm(x, g, eps=EPS):
    xf = x.astype(jnp.float32)
    y = xf * lax.rsqrt(jnp.mean(xf * xf, axis=-1, keepdims=True) + eps)
    return (y * g.astype(jnp.float32)).astype(x.dtype)


def rope_tables(seq_len, dim):
    inv = ROPE_THETA ** (-jnp.arange(0, dim, 2, dtype=jnp.float32) / dim)
    ang = jnp.arange(seq_len, dtype=jnp.float32)[:, None] * inv[None, :]
    return jnp.cos(ang), jnp.sin(ang)


def apply_rope(x, cos, sin):
    c = cos[None, :, None, :].astype(x.dtype)
    s = sin[None, :, None, :].astype(x.dtype)
    x1, x2 = jnp.split(x, 2, axis=-1)
    return jnp.concatenate([x1 * c - x2 * s, x2 * c + x1 * s], axis=-1)


def short_conv(u, w, b):
    up = jnp.pad(u, ((0, 0), (1, 1), (0, 0)))
    return up[:, :-2] * w[0] + up[:, 1:-1] * w[1] + up[:, 2:] * w[2] + b


def hyena_filters(seq_len, w1, b1, w2, b2, w3, freq):
    f32 = jnp.float32
    t = jnp.linspace(0.0, 1.0, seq_len, dtype=f32)[:, None]
    w = (2.0 * math.pi / seq_len) * jnp.arange(seq_len, dtype=f32)[:, None]
    bands = jnp.linspace(1e-4, HY_BANDS - 1, HY_BANDS, dtype=f32)[None, :]
    feats = jnp.concatenate([t, jnp.cos(bands * w), -jnp.sin(bands * w)], axis=-1)
    fr = freq.astype(f32)
    a = jnp.sin(fr * (feats @ w1.astype(f32) + b1.astype(f32)))
    a = jnp.sin(fr * (a @ w2.astype(f32) + b2.astype(f32)))
    h = (a @ w3.astype(f32)).reshape(seq_len, HY_ORDER, 2, HY_CH)
    max_decay = math.log(HY_TARGET) / HY_FAST_PCT
    min_decay = math.log(HY_TARGET) / HY_SLOW_PCT
    deltas = jnp.linspace(min_decay, max_decay, HY_CH, dtype=f32)
    window = jnp.exp(-t * jnp.abs(deltas)[None, :])
    return h * window[:, None, None, :]


def two_sided_long_conv(z, h_fwd, h_bwd):
    L = z.shape[1]
    k = jnp.concatenate([h_fwd, jnp.zeros((1, h_fwd.shape[1]), h_fwd.dtype), h_bwd[:0:-1]], axis=0)
    kf = jnp.fft.rfft(k, n=2 * L, axis=0)
    zf = jnp.fft.rfft(z.astype(jnp.float32), n=2 * L, axis=1)
    y = jnp.fft.irfft(zf * kf[None], n=2 * L, axis=1)[:, :L]
    return y.astype(z.dtype)


def block_attention(q, k, v, scale):
    B, S, H, dk = q.shape
    nb = S // Q_BLOCK
    qb = jnp.moveaxis(q.reshape(B, nb, Q_BLOCK, H, dk), 1, 0)

    def one(qblk):
        s = jnp.einsum('bqhd,bkhd->bhqk', qblk, k).astype(jnp.float32) * scale
        p = jax.nn.softmax(s, axis=-1).astype(v.dtype)
        return jnp.einsum('bhqk,bkhe->bqhe', p, v)

    o = lax.map(one, qb)
    return jnp.moveaxis(o, 0, 1).reshape(B, S, H, v.shape[-1])


def diff_block_attention(q, k, v, lam):
    B, S, H2, d = q.shape
    H = H2 // 2
    nb = S // Q_BLOCK
    qb = jnp.moveaxis(q.reshape(B, nb, Q_BLOCK, H2, d), 1, 0)
    scale = d ** -0.5

    def one(qblk):
        s = jnp.einsum('bqhd,bkhd->bhqk', qblk, k).astype(jnp.float32) * scale
        p = jax.nn.softmax(s, axis=-1).reshape(B, H, 2, Q_BLOCK, S)
        a = (p[:, :, 0] - lam * p[:, :, 1]).astype(v.dtype)
        return jnp.einsum('bhqk,bkhe->bqhe', a, v)

    o = lax.map(one, qb)
    return jnp.moveaxis(o, 0, 1).reshape(B, S, H, v.shape[-1])


def even_mixer(h, w_in, conv_w, conv_b, hy_w1, hy_b1, hy_w2, hy_b2, hy_w3, hy_freq, hy_skip,
               q_norm, w_uq, kv_norm, w_ukv, w_out, cos_r, sin_r):
    B, S, _ = h.shape
    proj = h @ w_in
    c0 = (HY_ORDER + 1) * HY_CH
    c1 = c0 + MLA_Q_RANK
    c2 = c1 + MLA_KV_RANK
    hy, cq, ckv, kr = jnp.split(proj, [c0, c1, c2], axis=-1)

    hy = short_conv(hy, conv_w, conv_b)
    v, x1, x2 = jnp.split(hy, 3, axis=-1)
    filt = hyena_filters(S, hy_w1, hy_b1, hy_w2, hy_b2, hy_w3, hy_freq)
    z = v
    for o, gate in enumerate((x1, x2)):
        z = gate * (two_sided_long_conv(z, filt[:, o, 0], filt[:, o, 1]) + hy_skip[o].astype(z.dtype) * z)

    q = (rms_norm(cq, q_norm) @ w_uq).reshape(B, S, MLA_HEADS, MLA_QK)
    q_nope, q_pe = jnp.split(q, [MLA_NOPE], axis=-1)
    q_pe = apply_rope(q_pe, cos_r, sin_r)
    kv = (rms_norm(ckv, kv_norm) @ w_ukv).reshape(B, S, MLA_HEADS, MLA_NOPE + MLA_V)
    k_nope, vv = jnp.split(kv, [MLA_NOPE], axis=-1)
    k_pe = apply_rope(kr[:, :, None, :], cos_r, sin_r)
    qf = jnp.concatenate([q_nope, q_pe], axis=-1)
    kf = jnp.concatenate([k_nope, jnp.broadcast_to(k_pe, (B, S, MLA_HEADS, MLA_ROPE))], axis=-1)
    o_mla = block_attention(qf, kf, vv, MLA_QK ** -0.5).reshape(B, S, MLA_HEADS * MLA_V)

    return jnp.concatenate([z, o_mla], axis=-1) @ w_out


def odd_mixer(h, w_qkv, lq1, lk1, lq2, lk2, subln, w_out, cos_d, sin_d, lam_init):
    B, S, _ = h.shape
    q, k, v = jnp.split(h @ w_qkv, 3, axis=-1)
    q = apply_rope(q.reshape(B, S, 2 * DIFF_HEADS, DIFF_HD), cos_d, sin_d)
    k = apply_rope(k.reshape(B, S, 2 * DIFF_HEADS, DIFF_HD), cos_d, sin_d)
    v = v.reshape(B, S, DIFF_HEADS, 2 * DIFF_HD)
    f32 = jnp.float32
    lam = (jnp.exp(jnp.sum(lq1.astype(f32) * lk1.astype(f32)))
           - jnp.exp(jnp.sum(lq2.astype(f32) * lk2.astype(f32))) + lam_init)
    o = diff_block_attention(q, k, v, lam)
    o = rms_norm(o, subln, SUBLN_EPS) * (1.0 - lam_init)
    return o.reshape(B, S, D_MODEL) @ w_out


def cross_attention(h, mem_n, wq, wkv, wo):
    B, S, _ = h.shape
    M = mem_n.shape[1]
    q = (h @ wq).reshape(B, S, X_HEADS, X_HD)
    k, v = jnp.split(mem_n @ wkv, 2, axis=-1)
    k = k.reshape(B, M, X_HEADS, X_HD)
    v = v.reshape(B, M, X_HEADS, X_HD)
    s = jnp.einsum('bqhd,bkhd->bhqk', q, k).astype(jnp.float32) * (X_HD ** -0.5)
    p = jax.nn.softmax(s, axis=-1).astype(v.dtype)
    o = jnp.einsum('bhqk,bkhd->bqhd', p, v).reshape(B, S, D_MODEL)
    return o @ wo


def sq_relu_mlp(h, w_up, w_down):
    return jnp.square(jax.nn.relu(h @ w_up)) @ w_down


def setup_inputs(seed: int = 0) -> dict:
    key = jax.random.key(seed)
    keys = iter(jax.random.split(key, 48))
    f32 = jnp.float32
    D = D_MODEL
    E, O, L = N_EVEN, N_ODD, DEPTH

    def normal(shape, std):
        return std * jax.random.normal(next(keys), shape, f32)

    def gain(shape):
        return 1.0 + normal(shape, 0.02)

    return {
        "x": normal((BATCH, SEQ, D), 1.0),
        "mem": normal((BATCH, N_MEM, D), 1.0),
        "ev_w_in": normal((E, D, IN_EVEN), D ** -0.5),
        "ev_conv_w": normal((E, 3, (HY_ORDER + 1) * HY_CH), 3 ** -0.5),
        "ev_conv_b": normal((E, (HY_ORDER + 1) * HY_CH), 0.02),
        "hy_w1": normal((E, HY_EMB, HY_FFN), HY_EMB ** -0.5),
        "hy_b1": normal((E, HY_FFN), 0.1),
        "hy_w2": normal((E, HY_FFN, HY_FFN), HY_FFN ** -0.5),
        "hy_b2": normal((E, HY_FFN), 0.1),
        "hy_w3": normal((E, HY_FFN, HY_ORDER * 2 * HY_CH), 0.05 * HY_FFN ** -0.5),
        "hy_freq": gain((E, HY_FFN)),
        "hy_skip": normal((E, HY_ORDER, HY_CH), 0.5),
        "mla_q_norm": gain((E, MLA_Q_RANK)),
        "mla_w_uq": normal((E, MLA_Q_RANK, MLA_HEADS * MLA_QK), MLA_Q_RANK ** -0.5),
        "mla_kv_norm": gain((E, MLA_KV_RANK)),
        "mla_w_ukv": normal((E, MLA_KV_RANK, MLA_HEADS * (MLA_NOPE + MLA_V)), MLA_KV_RANK ** -0.5),
        "ev_w_out": normal((E, MIX_EVEN, D), MIX_EVEN ** -0.5),
        "od_w_qkv": normal((O, D, 3 * D), D ** -0.5),
        "dif_lq1": normal((O, DIFF_HD), 0.1),
        "dif_lk1": normal((O, DIFF_HD), 0.1),
        "dif_lq2": normal((O, DIFF_HD), 0.1),
        "dif_lk2": normal((O, DIFF_HD), 0.1),
        "dif_subln": gain((O, 2 * DIFF_HD)),
        "od_w_out": normal((O, D, D), D ** -0.5),
        "norm_mix": gain((L, D)),
        "norm_cross": gain((L, D)),
        "norm_mlp": gain((L, D)),
        "xa_wq": normal((L, D, D), D ** -0.5),
        "xa_wkv": normal((L, D, 2 * D), D ** -0.5),
        "xa_wo": normal((L, D, D), D ** -0.5),
        "mlp_up": normal((L, D, D_FF), D ** -0.5),
        "mlp_down": normal((L, D_FF, D), D_FF ** -0.5),
        "mem_norm": gain((D,)),
        "final_norm": gain((D,)),
    }


def reference(x, mem, ev_w_in, ev_conv_w, ev_conv_b, hy_w1, hy_b1, hy_w2, hy_b2, hy_w3, hy_freq,
              hy_skip, mla_q_norm, mla_w_uq, mla_kv_norm, mla_w_ukv, ev_w_out, od_w_qkv, dif_lq1,
              dif_lk1, dif_lq2, dif_lk2, dif_subln, od_w_out, norm_mix, norm_cross, norm_mlp, xa_wq,
              xa_wkv, xa_wo, mlp_up, mlp_down, mem_norm, final_norm):
    S = x.shape[1]
    mem_n = rms_norm(mem, mem_norm)
    cos_r, sin_r = rope_tables(S, MLA_ROPE)
    cos_d, sin_d = rope_tables(S, DIFF_HD)
    for i in range(DEPTH):
        j = i // 2
        h = rms_norm(x, norm_mix[i])
        if i % 2 == 0:
            x = x + even_mixer(h, ev_w_in[j], ev_conv_w[j], ev_conv_b[j], hy_w1[j], hy_b1[j],
                               hy_w2[j], hy_b2[j], hy_w3[j], hy_freq[j], hy_skip[j],
                               mla_q_norm[j], mla_w_uq[j], mla_kv_norm[j], mla_w_ukv[j],
                               ev_w_out[j], cos_r, sin_r)
        else:
            lam_init = 0.8 - 0.6 * math.exp(-0.3 * i)
            x = x + odd_mixer(h, od_w_qkv[j], dif_lq1[j], dif_lk1[j], dif_lq2[j], dif_lk2[j],
                              dif_subln[j], od_w_out[j], cos_d, sin_d, lam_init)
        x = x + cross_attention(rms_norm(x, norm_cross[i]), mem_n, xa_wq[i], xa_wkv[i], xa_wo[i])
        x = x + sq_relu_mlp(rms_norm(x, norm_mlp[i]), mlp_up[i], mlp_down[i])
    return rms_norm(x, final_norm)
```

```cpp
#include <hip/hip_runtime.h>
#include <hip/hip_cooperative_groups.h>
#include <cstdio>
#include <cstdint>
namespace cg = cooperative_groups;

#define LAS __attribute__((address_space(3)))
typedef unsigned short bf16_t;
typedef short bf16x8 __attribute__((ext_vector_type(8)));
typedef short s16x4 __attribute__((ext_vector_type(4)));
typedef float f32x4 __attribute__((ext_vector_type(4)));
typedef float f32x16 __attribute__((ext_vector_type(16)));
typedef unsigned u32x4 __attribute__((ext_vector_type(4)));
typedef unsigned u32x2 __attribute__((ext_vector_type(2)));

constexpr int T_TOK = 32768, SEQ = 2048, NB = 16, DM = 1024, NMEM = 256, DFF = 4096;
constexpr float EPS = 1e-6f, SUBLN_EPS = 1e-5f;
constexpr float LOG2E = 1.4426950408889634f;
constexpr float LAM_INIT = 0.35550906758f;
constexpr int NTHREADS = 512, NWAVES = 8;
constexpr int LDS_BYTES = 147456;

constexpr size_t MiB = 1u << 20;
constexpr size_t WS_ROPE_R = 1 * MiB;
constexpr size_t WS_ROPE_D = 1 * MiB + 512 * 1024;
constexpr size_t WS_RSS = 2 * MiB;
constexpr size_t WS_LSS = 4 * MiB;
constexpr size_t WS_FILT = 8 * MiB;
constexpr size_t WS_MEMK = 16 * MiB;
constexpr size_t WS_VT = 32 * MiB;
constexpr size_t WS_PBUF = 248 * MiB;
constexpr size_t WS_MEMN = 48 * MiB;
constexpr size_t WS_W_IN = 56 * MiB;
constexpr size_t WS_W_UQ = 60 * MiB;
constexpr size_t WS_W_UKV = 60 * MiB + 512 * 1024;
constexpr size_t WS_W_OUT0 = 61 * MiB;
constexpr size_t WS_W_QKV = 63 * MiB;
constexpr size_t WS_W_OUT1 = 69 * MiB;
constexpr size_t WS_W_XKV = 71 * MiB;
constexpr size_t WS_W_XQ = 79 * MiB;
constexpr size_t WS_W_XO = 83 * MiB;
constexpr size_t WS_W_UP = 87 * MiB;
constexpr size_t WS_W_DN = 103 * MiB;
constexpr size_t WS_XB = 120 * MiB;
constexpr size_t WS_ACT1 = 184 * MiB;
constexpr size_t WS_BIG = 248 * MiB;
constexpr size_t WS_HYT = WS_BIG;
constexpr size_t WS_LAT = WS_BIG + 96 * MiB;
constexpr size_t WS_QM = WS_BIG + 120 * MiB;
constexpr size_t WS_KM = WS_BIG + 168 * MiB;
constexpr size_t WS_VM = WS_BIG + 216 * MiB;
constexpr size_t WS_QKV = WS_BIG;
constexpr size_t WS_HMID = WS_BIG;
constexpr size_t WS_END = 504 * MiB;

struct Args { const float* in[34]; float* out; unsigned char* ws; int ph_lo, ph_hi; };

__device__ __forceinline__ int lane_id() { int l; asm volatile("v_mbcnt_lo_u32_b32 %0, -1, 0\n\tv_mbcnt_hi_u32_b32 %0, -1, %0" : "=v"(l)); return l; }
__device__ __forceinline__ unsigned cvt_pk_bf16(float lo, float hi) { unsigned r; asm volatile("v_cvt_pk_bf16_f32 %0, %1, %2" : "=v"(r) : "v"(lo), "v"(hi)); return r; }
__device__ __forceinline__ unsigned f2bf(float f) { unsigned u = __builtin_bit_cast(unsigned, f); return (u + 0x7fffu + ((u >> 16) & 1u)) >> 16; }
__device__ __forceinline__ float bf2f(unsigned short b) { return __builtin_bit_cast(float, (unsigned)b << 16); }
__device__ __forceinline__ float shx(float v, int mask) { const int l = lane_id(); return __builtin_bit_cast(float, __builtin_amdgcn_ds_bpermute((l ^ mask) << 2, __builtin_bit_cast(int, v))); }
__device__ __forceinline__ float wave_sum(float v) {
#pragma unroll
    for (int o = 1; o < 64; o <<= 1) v += shx(v, o);
    return v;
}
__device__ __forceinline__ u32x4 pack8(const float (&v)[8]) { u32x4 w; w.x = cvt_pk_bf16(v[0], v[1]); w.y = cvt_pk_bf16(v[2], v[3]); w.z = cvt_pk_bf16(v[4], v[5]); w.w = cvt_pk_bf16(v[6], v[7]); return w; }

namespace pg8 {
constexpr int BM = 256, BK = 64, HALF = 128, HTB = HALF * BK * 2, STAGE_BYTES = 8 * HTB, NXCD = 8, WGM = 8;
__host__ __device__ __forceinline__ int lds_byte(int r, int c) { const int st = (r >> 4) * 2 + (c >> 5), rr = r & 15, cc = c & 31, ob = rr * 64 + cc * 2; return st * 1024 + (ob ^ (((ob >> 9) & 1) << 5)); }
__host__ __device__ __forceinline__ void stage_rc(int b, int& R, int& C) { const int st = b / 1024, sb = b % 1024, swz = sb ^ (((sb >> 9) & 1) << 5); R = (st >> 1) * 16 + swz / 64; C = (st & 1) * 32 + (swz % 64) / 2; }
__host__ __device__ __forceinline__ int perm32(int rho) { const int n = rho >> 4, i = rho & 15; return 8 * (i >> 2) + 4 * n + (i & 3); }
struct Unit { int pm, pn; };
struct Gemm { const bf16_t* A; const bf16_t* Bt; int M, N, K, lda, ldb; };
struct AddrStd {
    const char* A; const char* B; size_t tA, tB;
    __device__ __forceinline__ const char* a(const Unit& u) const { return A + (size_t)u.pm * tA; }
    __device__ __forceinline__ const char* b(const Unit& u) const { return B + (size_t)u.pn * tB; }
};
struct StaticOrder {
    int nM, nN, nwg, G, c;
    __device__ void init(int M, int N, int G_, int c_) { nM = M / BM; nN = N / BM; nwg = nM * nN; G = G_; c = c_; }
    __device__ bool next(int i, Unit& u) const {
        const long L = (long)i * G + c; if (L >= nwg) return false;
        int wgid = (int)L; { const int q = nwg / NXCD, r = nwg % NXCD, xcd = wgid % NXCD, off = wgid / NXCD; wgid = (xcd < r ? xcd * (q + 1) : r * (q + 1) + (xcd - r) * q) + off; }
        const int nig = WGM * nN, gid = wgid / nig, fm = gid * WGM, gsz = (nM - fm) < WGM ? (nM - fm) : WGM;
        u.pm = fm + ((wgid % nig) % gsz); u.pn = (wgid % nig) / gsz; return true;
    }
};

template <class Epi, class Addr>
__device__ __forceinline__ void gemm_phase(LAS unsigned char* lds, int wave0, const Gemm g, const StaticOrder& S, const Epi& E, const Addr& AD) {
    int tid_ = wave0 * 64 + lane_id(); asm volatile("" : "+v"(tid_));
    const int tid = tid_, wid = __builtin_amdgcn_readfirstlane(tid >> 6), lane = tid & 63, wr = wid >> 2, wc = wid & 3, fr = lane & 15, fq = lane >> 4;
    const int K = g.K, nt = K / BK;
    unsigned voffA[2], voffB[2];
#pragma unroll
    for (int i = 0; i < 2; ++i) { int R, C; stage_rc(tid * 16 + i * 8192, R, C); const int Rb = ((R & ~31) + perm32(R & 31));
        voffA[i] = (unsigned)(R * g.lda + C) * 2u; voffB[i] = (unsigned)(Rb * g.ldb + C) * 2u; }
    const size_t kstep = (size_t)(BK * 2);
    const size_t hstepA = (size_t)HALF * g.lda * 2, hstepB = (size_t)HALF * g.ldb * 2;
    const unsigned ldsw = (unsigned)wid * 1024u;
    const int aoff = lds_byte(wr * 64 + fr, fq * 8), boff = lds_byte(wc * 32 + fr, fq * 8);
#define PG8_SA(b, h) (((b) * 2 + (h)) * HTB)
#define PG8_SB(b, h) ((4 + (b) * 2 + (h)) * HTB)
#define PG8_STAGE(bufoff, gbase, voff) do { _Pragma("unroll") for (int _i = 0; _i < 2; ++_i) \
        __builtin_amdgcn_global_load_lds((const unsigned*)((const char*)(gbase) + (voff)[_i]), (LAS unsigned*)(lds + (bufoff) + ldsw + _i * 8192), 16, 0, 0); } while (0)
#define PG8_LDA(dst, b, h) do { _Pragma("unroll") for (int m = 0; m < 4; ++m) _Pragma("unroll") for (int k = 0; k < 2; ++k) dst[m][k] = *(const LAS bf16x8*)(lds + PG8_SA(b, h) + aoff + m * 2048 + k * 1024); } while (0)
#define PG8_LDB(dst, b, h) do { _Pragma("unroll") for (int n = 0; n < 2; ++n) _Pragma("unroll") for (int k = 0; k < 2; ++k) dst[n][k] = *(const LAS bf16x8*)(lds + PG8_SB(b, h) + boff + n * 2048 + k * 1024); } while (0)
#define PG8_MMA(ai, bj, At, Bt) do { __builtin_amdgcn_s_setprio(1); _Pragma("unroll") for (int m = 0; m < 4; ++m) _Pragma("unroll") for (int n = 0; n < 2; ++n) _Pragma("unroll") for (int k = 0; k < 2; ++k) \
        acc[ai][bj][m][n] = __builtin_amdgcn_mfma_f32_16x16x32_bf16(Bt[n][k], At[m][k], acc[ai][bj][m][n], 0, 0, 0); __builtin_amdgcn_s_setprio(0); } while (0)
#define PG8_WAIT_V(n) asm volatile("s_waitcnt vmcnt(" #n ")" ::: "memory")
#define PG8_WAIT_L(n) asm volatile("s_waitcnt lgkmcnt(" #n ")" ::: "memory")
#define PG8_BAR __builtin_amdgcn_s_barrier()
#define PG8_SCHED __builtin_amdgcn_sched_barrier(0)
    Unit cur, nxt; int ui = 0;
    if (!S.next(0, cur)) return;
    E.prep(lds, S, tid);
    f32x4 acc[2][2][4][2];
#pragma unroll
    for (int a = 0; a < 2; ++a)
#pragma unroll
        for (int b = 0; b < 2; ++b)
#pragma unroll
            for (int m = 0; m < 4; ++m)
#pragma unroll
                for (int n = 0; n < 2; ++n) acc[a][b][m][n] = (f32x4){0.f, 0.f, 0.f, 0.f};
    bf16x8 At[4][2], B0[2][2], B1[2][2];
    const char* cA = AD.a(cur); const char* cB = AD.b(cur);
    {
        PG8_STAGE(PG8_SB(0, 0), cB, voffB); PG8_STAGE(PG8_SB(0, 1), cB + hstepB, voffB); PG8_STAGE(PG8_SA(0, 0), cA, voffA); PG8_STAGE(PG8_SA(0, 1), cA + hstepA, voffA);
        if (wr == 1) PG8_BAR;
        PG8_WAIT_V(2); PG8_BAR;
        PG8_STAGE(PG8_SB(1, 0), cB + kstep, voffB); PG8_STAGE(PG8_SA(1, 0), cA + kstep, voffA); PG8_STAGE(PG8_SB(1, 1), cB + hstepB + kstep, voffB);
        PG8_WAIT_V(6); PG8_BAR;
    }
    for (;;) {
        const bool has_next = S.next(ui + 1, nxt);
        const char* nA = has_next ? AD.a(nxt) : cA; const char* nB = has_next ? AD.b(nxt) : cB;
        for (int t = 0; t < nt; t += 2) {
            const bool last = (t == nt - 2);
            const char* a1 = cA + (size_t)(t + 1) * kstep;
            const char* a2 = last ? nA : cA + (size_t)(t + 2) * kstep; const char* b2 = last ? nB : cB + (size_t)(t + 2) * kstep;
            const char* a3 = a2 + kstep; const char* b3 = b2 + kstep;
            PG8_LDB(B0, 0, 0); PG8_LDB(B1, 0, 1); PG8_SCHED; PG8_LDA(At, 0, 0); PG8_STAGE(PG8_SA(1, 1), a1 + hstepA, voffA);
            PG8_WAIT_V(8); PG8_WAIT_L(0); PG8_BAR; PG8_MMA(0, 0, At, B0); PG8_MMA(0, 1, At, B1); PG8_BAR; PG8_SCHED;
            PG8_LDA(At, 0, 1); PG8_STAGE(PG8_SB(0, 0), b2, voffB); PG8_STAGE(PG8_SB(0, 1), b2 + hstepB, voffB); PG8_STAGE(PG8_SA(0, 0), a2, voffA);
            PG8_WAIT_V(8); PG8_WAIT_L(0); PG8_BAR; PG8_MMA(1, 0, At, B0); PG8_MMA(1, 1, At, B1); PG8_BAR; PG8_SCHED;
            PG8_LDB(B0, 1, 0); PG8_LDB(B1, 1, 1); PG8_SCHED; PG8_LDA(At, 1, 0); PG8_STAGE(PG8_SA(0, 1), a2 + hstepA, voffA);
            PG8_WAIT_V(8); PG8_WAIT_L(0); PG8_BAR; PG8_MMA(0, 0, At, B0); PG8_MMA(0, 1, At, B1); PG8_BAR; PG8_SCHED;
            PG8_LDA(At, 1, 1); PG8_STAGE(PG8_SB(1, 0), b3, voffB); PG8_STAGE(PG8_SB(1, 1), b3 + hstepB, voffB); PG8_STAGE(PG8_SA(1, 0), a3, voffA);
            PG8_WAIT_V(8); PG8_WAIT_L(0); PG8_BAR; PG8_MMA(1, 0, At, B0); PG8_MMA(1, 1, At, B1); PG8_BAR; PG8_SCHED;
        }
        if (wr == 0) PG8_BAR;
        E(acc, cur, wr, wc, lds, ui);
        if (!has_next) break;
#pragma unroll
        for (int a = 0; a < 2; ++a)
#pragma unroll
            for (int b = 0; b < 2; ++b)
#pragma unroll
                for (int m = 0; m < 4; ++m)
#pragma unroll
                    for (int n = 0; n < 2; ++n) acc[a][b][m][n] = (f32x4){0.f, 0.f, 0.f, 0.f};
        cur = nxt; cA = nA; cB = nB; ++ui;
        if (wr == 1) PG8_BAR;
    }
    PG8_WAIT_V(0);
    PG8_BAR;
#undef PG8_SA
#undef PG8_SB
#undef PG8_STAGE
#undef PG8_LDA
#undef PG8_LDB
#undef PG8_MMA
#undef PG8_WAIT_V
#undef PG8_WAIT_L
#undef PG8_BAR
#undef PG8_SCHED
}

template <class F> struct Epi8 {
    F f;
    __device__ __forceinline__ void prep(LAS unsigned char* lds, const StaticOrder& S, int tid) const {
        if constexpr (F::HAS_PREP) {
            LAS float* tab = (LAS float*)(lds + STAGE_BYTES);
            Unit u;
            for (int i = 0; i < 8 && S.next(i, u); ++i) if (tid < 256) tab[i * 256 + tid] = f.rowstat(u.pm * BM + tid);
            asm volatile("s_waitcnt vmcnt(0) lgkmcnt(0)" ::: "memory");
        }
    }
    __device__ __forceinline__ void operator()(f32x4 (&acc)[2][2][4][2], const Unit& u, int wr, int wc, LAS unsigned char* lds, int ui) const {
        int ln = lane_id(); asm volatile("" : "+v"(ln));
        const int fr = ln & 15, fq = ln >> 4;
        const int colt = u.pn * BM + wc * 32 + 8 * fq;
        const LAS float* tab = (const LAS float*)(lds + STAGE_BYTES) + ui * 256;
        if constexpr (F::HAS_TSTORE) if (u.pn < F::TSTORE_PN) {
            LAS unsigned char* stg = lds + STAGE_BYTES + (wr * 4 + wc) * 1280;
            const int chl = ln >> 2, part = ln & 3;
#pragma unroll
            for (int ai = 0; ai < 2; ++ai) {
                f32x4 rsv[4]; float rsf[4];
#pragma unroll
                for (int m = 0; m < 4; ++m) rsv[m] = f.rs_load(u.pm * BM + ai * HALF + wr * 64 + m * 16 + fr, fq);
#pragma unroll
                for (int m = 0; m < 4; ++m) rsf[m] = f.rs_finish(rsv[m]);
#pragma unroll
                for (int bj = 0; bj < 2; ++bj)
#pragma unroll
                    for (int mp = 0; mp < 2; ++mp)
#pragma unroll
                        for (int n = 0; n < 2; ++n) {
#pragma unroll
                            for (int mm = 0; mm < 2; ++mm)
#pragma unroll
                                for (int e = 0; e < 4; ++e)
                                    *(LAS bf16_t*)(stg + (4 * fq + e) * 80 + (16 * mm + fr) * 2) = (bf16_t)f2bf(acc[ai][bj][2 * mp + mm][n][e] * rsf[2 * mp + mm]);
                            asm volatile("s_waitcnt lgkmcnt(0)" ::: "memory");
                            const u32x4 w = *(const LAS u32x4*)(stg + chl * 80 + part * 16);
                            const int ch = u.pn * BM + bj * HALF + wc * 32 + 8 * (chl >> 2) + 4 * n + (chl & 3);
                            const int tok = u.pm * BM + ai * HALF + wr * 64 + mp * 32 + 8 * part;
                            f.tstore(ch, tok, w);
                            asm volatile("s_waitcnt lgkmcnt(0)" ::: "memory");
                        }
            }
            return;
        }
#pragma unroll
        for (int ai = 0; ai < 2; ++ai) {
            f32x4 rsv[4]; u32x4 xv[4][2];
            if constexpr (F::HAS_RSLOAD) {
#pragma unroll
                for (int m = 0; m < 4; ++m) rsv[m] = f.rs_load(u.pm * BM + ai * HALF + wr * 64 + m * 16 + fr, fq);
            }
            if constexpr (F::HAS_XLOAD) {
#pragma unroll
                for (int m = 0; m < 4; ++m)
#pragma unroll
                    for (int bj = 0; bj < 2; ++bj) xv[m][bj] = f.x_load(u.pm * BM + ai * HALF + wr * 64 + m * 16 + fr, colt + bj * HALF);
            }
#pragma unroll
            for (int m = 0; m < 4; ++m) {
                const int rl = ai * HALF + wr * 64 + m * 16 + fr;
                const int row = u.pm * BM + rl;
                float rs;
                if constexpr (F::HAS_PREP) rs = tab[rl]; else if constexpr (F::HAS_RSLOAD) rs = f.rs_finish(rsv[m]); else rs = 1.0f;
                float ss = 0.f;
#pragma unroll
                for (int bj = 0; bj < 2; ++bj) {
                    float v[8];
#pragma unroll
                    for (int n = 0; n < 2; ++n)
#pragma unroll
                        for (int e = 0; e < 4; ++e) v[4 * n + e] = acc[ai][bj][m][n][e] * rs;
                    if constexpr (F::HAS_XLOAD) f.store_x(row, colt + bj * HALF, v, ss, xv[m][bj]); else f.store(row, colt + bj * HALF, v, ss);
                }
                if (F::HAS_SS) { ss += shx(ss, 16); ss += shx(ss, 32); if (fq == 0) f.put_ss(row, u.pn, wc, ss); }
            }
            asm volatile("" ::: "memory");
        }
    }
};
struct EpiSoftmax {
    bf16_t* P; int ldp;
    __device__ __forceinline__ void prep(LAS unsigned char*, const StaticOrder&, int) const {}
    __device__ __forceinline__ void operator()(f32x4 (&acc)[2][2][4][2], const Unit& u, int wr, int wc, LAS unsigned char* lds, int) const {
        int ln = lane_id(); asm volatile("" : "+v"(ln));
        const int fr = ln & 15, fq = ln >> 4;
        LAS float* smax = (LAS float*)(lds + STAGE_BYTES);
        LAS float* ssum = (LAS float*)(lds + STAGE_BYTES + 4096);
#pragma unroll
        for (int ai = 0; ai < 2; ++ai)
#pragma unroll
            for (int m = 0; m < 4; ++m) {
                float mx = acc[ai][0][m][0][0];
#pragma unroll
                for (int bj = 0; bj < 2; ++bj)
#pragma unroll
                    for (int n = 0; n < 2; ++n)
#pragma unroll
                        for (int e = 0; e < 4; ++e) mx = fmaxf(mx, acc[ai][bj][m][n][e]);
                mx = fmaxf(mx, shx(mx, 16)); mx = fmaxf(mx, shx(mx, 32));
                if (fq == 0) smax[(ai * HALF + wr * 64 + m * 16 + fr) * 4 + wc] = mx;
            }
        asm volatile("s_waitcnt lgkmcnt(0)" ::: "memory"); __builtin_amdgcn_s_barrier(); asm volatile("" ::: "memory");
#pragma unroll
        for (int ai = 0; ai < 2; ++ai)
#pragma unroll
            for (int m = 0; m < 4; ++m) {
                const int rl = ai * HALF + wr * 64 + m * 16 + fr;
                const f32x4 t = *(const LAS f32x4*)(smax + rl * 4);
                const float mx = fmaxf(fmaxf(t.x, t.y), fmaxf(t.z, t.w));
                float sm = 0.f;
#pragma unroll
                for (int bj = 0; bj < 2; ++bj)
#pragma unroll
                    for (int n = 0; n < 2; ++n)
#pragma unroll
                        for (int e = 0; e < 4; ++e) { const float p = __builtin_amdgcn_exp2f(acc[ai][bj][m][n][e] - mx); acc[ai][bj][m][n][e] = p; sm += p; }
                sm += shx(sm, 16); sm += shx(sm, 32);
                if (fq == 0) ssum[rl * 4 + wc] = sm;
            }
        asm volatile("s_waitcnt lgkmcnt(0)" ::: "memory"); __builtin_amdgcn_s_barrier(); asm volatile("" ::: "memory");
        const int colt = u.pn * BM + wc * 32 + 8 * fq;
#pragma unroll
        for (int ai = 0; ai < 2; ++ai)
#pragma unroll
            for (int m = 0; m < 4; ++m) {
                const int rl = ai * HALF + wr * 64 + m * 16 + fr;
                const f32x4 t = *(const LAS f32x4*)(ssum + rl * 4);
                const float inv = 1.0f / ((t.x + t.y) + (t.z + t.w));
#pragma unroll
                for (int bj = 0; bj < 2; ++bj) {
                    float v[8];
#pragma unroll
                    for (int n = 0; n < 2; ++n)
#pragma unroll
                        for (int e = 0; e < 4; ++e) v[4 * n + e] = acc[ai][bj][m][n][e] * inv;
                    *(u32x4*)(P + (size_t)(u.pm * BM + rl) * ldp + colt + bj * HALF) = pack8(v);
                }
            }
        asm volatile("s_waitcnt lgkmcnt(0)" ::: "memory");
    }
};
}

__device__ __forceinline__ float xnorm_full(const float* RSS, int row) {
    const f32x4* p = (const f32x4*)(RSS + (size_t)row * 16);
    const f32x4 a = p[0], b = p[1], c = p[2], d = p[3];
    const float s = (((a.x + a.y) + (a.z + a.w)) + ((b.x + b.y) + (b.z + b.w))) + (((c.x + c.y) + (c.z + c.w)) + ((d.x + d.y) + (d.z + d.w)));
    return __builtin_amdgcn_rsqf(s * (1.0f / DM) + EPS);
}
__device__ __forceinline__ float xnorm_scale(const float* RSS, int row, int fq) {
    const f32x4 t = *(const f32x4*)(RSS + (size_t)row * 16 + 4 * fq);
    float s = (t.x + t.y) + (t.z + t.w);
    s += shx(s, 16); s += shx(s, 32);
    return __builtin_amdgcn_rsqf(s * (1.0f / DM) + EPS);
}
template <int DIM> __device__ __forceinline__ void rope8(float (&v)[8], int pos, int i0) {
    const float fpos = (float)pos * 0.15915494309189535f;
#pragma unroll
    for (int j = 0; j < 4; ++j) {
        const float invf = __builtin_amdgcn_exp2f((float)(i0 + j) * (-2.0f * 13.287712379549449f / (float)DIM));
        const float rev = __builtin_amdgcn_fractf(fpos * invf);
        const float c = __builtin_amdgcn_cosf(rev), sn = __builtin_amdgcn_sinf(rev);
        const float a = v[2 * j], b = v[2 * j + 1]; v[2 * j] = a * c - b * sn; v[2 * j + 1] = b * c + a * sn;
    }
}
struct EpiIn {
    static constexpr bool HAS_SS = true, HAS_PREP = false, HAS_RSLOAD = true, HAS_XLOAD = false, HAS_TSTORE = true;
    static constexpr int TSTORE_PN = 6;
    const float* RSS; bf16_t* HYT; bf16_t* LAT; float* LSS; bf16_t* KM;
    __device__ __forceinline__ void tstore(int ch, int tok, u32x4 w) const { *(u32x4*)(HYT + (size_t)ch * T_TOK + tok) = w; }
    __device__ __forceinline__ float rowstat(int row) const { return xnorm_full(RSS, row); }
    __device__ __forceinline__ f32x4 rs_load(int row, int fq) const { return *(const f32x4*)(RSS + (size_t)row * 16 + 4 * fq); }
    __device__ __forceinline__ float rs_finish(f32x4 t) const { float s_ = (t.x + t.y) + (t.z + t.w); s_ += shx(s_, 16); s_ += shx(s_, 32); return __builtin_amdgcn_rsqf(s_ * (1.0f / DM) + EPS); }
    __device__ __forceinline__ void store(int row, int col0, float (&v)[8], float& ss) const {
        if (col0 < 1536) {
#pragma unroll
            for (int j = 0; j < 8; ++j) HYT[(size_t)(col0 + j) * T_TOK + row] = (bf16_t)f2bf(v[j]);
        } else if (col0 < 1920) {
            *(u32x4*)(LAT + (size_t)row * 384 + (col0 - 1536)) = pack8(v);
#pragma unroll
            for (int j = 0; j < 8; ++j) ss += v[j] * v[j];
        } else if (col0 < 1952) {
            rope8<32>(v, row & (SEQ - 1), (col0 - 1920) >> 1);
            const u32x4 w = pack8(v);
#pragma unroll
            for (int h = 0; h < 8; ++h) *(u32x4*)(KM + (size_t)row * 768 + h * 96 + 64 + (col0 - 1920)) = w;
        }
    }
    __device__ __forceinline__ void put_ss(int row, int pn, int wc, float ss) const {
        if (pn == 6) LSS[(size_t)row * 8 + wc] = ss; else if (pn == 7) LSS[(size_t)row * 8 + 4 + wc] = ss;
    }
};
struct EpiUq {
    static constexpr bool HAS_SS = false, HAS_PREP = false, HAS_RSLOAD = true, HAS_XLOAD = false, HAS_TSTORE = false;
    const float* LSS; bf16_t* QM;
    __device__ __forceinline__ f32x4 rs_load(int row, int) const { return *(const f32x4*)(LSS + (size_t)row * 8); }
    __device__ __forceinline__ float rs_finish(f32x4 t) const { return __builtin_amdgcn_rsqf(((t.x + t.y) + (t.z + t.w)) * (1.0f / 256) + EPS) * (0.10206207261596577f * LOG2E); }
    __device__ __forceinline__ void store(int row, int col0, float (&v)[8], float&) const {
        const int j = col0 % 96;
        if (j >= 64) rope8<32>(v, row & (SEQ - 1), (j - 64) >> 1);
        *(u32x4*)(QM + (size_t)row * 768 + col0) = pack8(v);
    }
    __device__ __forceinline__ void put_ss(int, int, int, float) const {}
};
struct EpiUkv {
    static constexpr bool HAS_SS = false, HAS_PREP = false, HAS_RSLOAD = true, HAS_XLOAD = false, HAS_TSTORE = false;
    const float* LSS; bf16_t* KM; bf16_t* VM;
    __device__ __forceinline__ f32x4 rs_load(int row, int) const { return *(const f32x4*)(LSS + (size_t)row * 8 + 4); }
    __device__ __forceinline__ float rs_finish(f32x4 t) const { return __builtin_amdgcn_rsqf(((t.x + t.y) + (t.z + t.w)) * (1.0f / 128) + EPS); }
    __device__ __forceinline__ void store(int row, int col0, float (&v)[8], float&) const {
        const int h = col0 >> 7, j = col0 & 127;
        if (j < 64) *(u32x4*)(KM + (size_t)row * 768 + h * 96 + j) = pack8(v);
        else *(u32x4*)(VM + (size_t)row * 512 + h * 64 + (j - 64)) = pack8(v);
    }
    __device__ __forceinline__ void put_ss(int, int, int, float) const {}
};
struct EpiRes {
    static constexpr bool HAS_SS = true, HAS_PREP = false, HAS_RSLOAD = false, HAS_XLOAD = true, HAS_TSTORE = false;
    const bf16_t* XBI; bf16_t* XB; float* RSS;
    __device__ __forceinline__ u32x4 x_load(int row, int col0) const { return *(const u32x4*)(XBI + (size_t)row * DM + col0); }
    __device__ __forceinline__ void store_x(int row, int col0, float (&v)[8], float& ss, u32x4 xo) const {
        const size_t off = (size_t)row * DM + col0;
        v[0] += __builtin_bit_cast(float, xo.x << 16); v[1] += __builtin_bit_cast(float, xo.x & 0xffff0000u);
        v[2] += __builtin_bit_cast(float, xo.y << 16); v[3] += __builtin_bit_cast(float, xo.y & 0xffff0000u);
        v[4] += __builtin_bit_cast(float, xo.z << 16); v[5] += __builtin_bit_cast(float, xo.z & 0xffff0000u);
        v[6] += __builtin_bit_cast(float, xo.w << 16); v[7] += __builtin_bit_cast(float, xo.w & 0xffff0000u);
        const u32x4 w = pack8(v);
        *(u32x4*)(XB + off) = w;
        const float r0 = __builtin_bit_cast(float, w.x << 16), r1 = __builtin_bit_cast(float, w.x & 0xffff0000u), r2 = __builtin_bit_cast(float, w.y << 16), r3 = __builtin_bit_cast(float, w.y & 0xffff0000u);
        const float r4 = __builtin_bit_cast(float, w.z << 16), r5 = __builtin_bit_cast(float, w.z & 0xffff0000u), r6 = __builtin_bit_cast(float, w.w << 16), r7 = __builtin_bit_cast(float, w.w & 0xffff0000u);
        ss += ((r0 * r0 + r1 * r1) + (r2 * r2 + r3 * r3)) + ((r4 * r4 + r5 * r5) + (r6 * r6 + r7 * r7));
    }
    __device__ __forceinline__ void store(int, int, float (&)[8], float&) const {}
    __device__ __forceinline__ void put_ss(int row, int pn, int wc, float ss) const { RSS[(size_t)row * 16 + pn * 4 + wc] = ss; }
};
struct EpiNormBf16 {
    static constexpr bool HAS_SS = false, HAS_PREP = true, HAS_RSLOAD = false, HAS_XLOAD = false, HAS_TSTORE = false;
    const float* RSS; bf16_t* O; int ldo; float extra;
    __device__ __forceinline__ float rowstat(int row) const { return xnorm_full(RSS, row) * extra; }
    __device__ __forceinline__ float rowscale(int, int) const { return 1.0f; }
    __device__ __forceinline__ void store(int row, int col0, float (&v)[8], float&) const { *(u32x4*)(O + (size_t)row * ldo + col0) = pack8(v); }
    __device__ __forceinline__ void put_ss(int, int, int, float) const {}
};
struct EpiUp {
    static constexpr bool HAS_SS = false, HAS_PREP = true, HAS_RSLOAD = false, HAS_XLOAD = false, HAS_TSTORE = false;
    const float* RSS; bf16_t* O;
    __device__ __forceinline__ float rowstat(int row) const { return xnorm_full(RSS, row); }
    __device__ __forceinline__ float rowscale(int, int) const { return 1.0f; }
    __device__ __forceinline__ void store(int row, int col0, float (&v)[8], float&) const {
#pragma unroll
        for (int j = 0; j < 8; ++j) { const float t = fmaxf(v[j], 0.f); v[j] = t * t; }
        *(u32x4*)(O + (size_t)row * DFF + col0) = pack8(v);
    }
    __device__ __forceinline__ void put_ss(int, int, int, float) const {}
};
struct EpiQkv {
    static constexpr bool HAS_SS = false, HAS_PREP = true, HAS_RSLOAD = false, HAS_XLOAD = false, HAS_TSTORE = false;
    const float* RSS; bf16_t* O;
    __device__ __forceinline__ float rowstat(int row) const { return xnorm_full(RSS, row); }
    __device__ __forceinline__ float rowscale(int, int) const { return 1.0f; }
    __device__ __forceinline__ void store(int row, int col0, float (&v)[8], float&) const {
        if (col0 < 2048) {
            rope8<64>(v, row & (SEQ - 1), (col0 & 63) >> 1);
            if (col0 < 1024) {
#pragma unroll
                for (int j = 0; j < 8; ++j) v[j] *= 0.125f * LOG2E;
            }
        }
        *(u32x4*)(O + (size_t)row * 3072 + col0) = pack8(v);
    }
    __device__ __forceinline__ void put_ss(int, int, int, float) const {}
};
struct EpiPlain {
    static constexpr bool HAS_SS = false, HAS_PREP = false, HAS_RSLOAD = false, HAS_XLOAD = false, HAS_TSTORE = false;
    bf16_t* O; int ldo;
    __device__ __forceinline__ float rowscale(int, int) const { return 1.0f; }
    __device__ __forceinline__ void store(int row, int col0, float (&v)[8], float&) const { *(u32x4*)(O + (size_t)row * ldo + col0) = pack8(v); }
    __device__ __forceinline__ void put_ss(int, int, int, float) const {}
};
struct EpiMemKV {
    static constexpr bool HAS_SS = false, HAS_PREP = false, HAS_RSLOAD = false, HAS_XLOAD = false, HAS_TSTORE = false;
    bf16_t* MEMK; bf16_t* VT;
    __device__ __forceinline__ float rowscale(int, int) const { return 1.0f; }
    __device__ __forceinline__ void store(int row, int col0, float (&v)[8], float&) const {
        const int l = col0 >> 11, rem = col0 & 2047;
        if (rem < 1024) *(u32x4*)(MEMK + (size_t)row * 2048 + l * 1024 + rem) = pack8(v);
        else {
            const int hd = rem - 1024, b = row >> 8, key = row & 255;
            bf16_t* dst = VT + ((size_t)(l * NB + b) * 1024 + hd) * 256 + key;
#pragma unroll
            for (int j = 0; j < 8; ++j) dst[j * 256] = (bf16_t)f2bf(v[j]);
        }
    }
    __device__ __forceinline__ void put_ss(int, int, int, float) const {}
};

template <class F>
__device__ __forceinline__ void run_gemm(LAS unsigned char* lds, int wave0, const bf16_t* A, int lda, const bf16_t* Bt, int ldb, int M, int N, int K, const F& f) {
    pg8::Gemm g{A, Bt, M, N, K, lda, ldb};
    pg8::StaticOrder S; S.init(M, N, (int)gridDim.x, (int)blockIdx.x);
    pg8::Epi8<F> E{f};
    pg8::AddrStd AD{(const char*)A, (const char*)Bt, (size_t)256 * lda * 2, (size_t)256 * ldb * 2};
    pg8::gemm_phase<pg8::Epi8<F>, pg8::AddrStd>(lds, wave0, g, S, E, AD);
}
template <class Epi, class Addr>
__device__ __forceinline__ void run_gemm_ad(LAS unsigned char* lds, int wave0, int lda, int ldb, int M, int N, int K, const Epi& E, const Addr& AD) {
    pg8::Gemm g{nullptr, nullptr, M, N, K, lda, ldb};
    pg8::StaticOrder S; S.init(M, N, (int)gridDim.x, (int)blockIdx.x);
    pg8::gemm_phase<Epi, Addr>(lds, wave0, g, S, E, AD);
}
struct AddrXS {
    const char* Q; const char* Kmem;
    __device__ __forceinline__ const char* a(const pg8::Unit& u) const { return Q + ((size_t)u.pm * 256 * DM + u.pn * 256) * 2; }
    __device__ __forceinline__ const char* b(const pg8::Unit& u) const { return Kmem + ((size_t)(u.pm >> 3) * NMEM * 2048 + u.pn * 256) * 2; }
};
struct AddrXV {
    const char* Pm; const char* VT;
    __device__ __forceinline__ const char* a(const pg8::Unit& u) const { return Pm + ((size_t)u.pm * 256 * DM + u.pn * 256) * 2; }
    __device__ __forceinline__ const char* b(const pg8::Unit& u) const { return VT + ((size_t)((u.pm >> 3) * 4 + u.pn) * 65536) * 2; }
};

template <int MODE> struct ACfg;
template <> struct ACfg<0> { static constexpr int KW = 96, NQK = 6, VW = 64, NVB = 2, NRG = 8, NT = 32; };
template <> struct ACfg<1> { static constexpr int KW = 128, NQK = 4, VW = 128, NVB = 4, NRG = 4, NT = 32; };
template <> struct ACfg<2> { static constexpr int KW = 256, NQK = 16, VW = 256, NVB = 4, NRG = 4, NT = 4; };

__device__ __forceinline__ int crow(int r, int hi) { return (r & 3) + 8 * (r >> 2) + 4 * hi; }
template <int NCB> __device__ __forceinline__ int v_st(int k, int c) { const int kk = (k & ~0xC) | ((k & 4) << 1) | ((k & 8) >> 1); return ((kk >> 3) * NCB + (c >> 5)) * 512 + ((kk & 7) * 32 + (c & 31)) * 2; }
__device__ __forceinline__ int v_rd_base(int lane) { return ((lane & 3) << 3) | (((lane >> 2) & 3) << 6) | (((lane >> 4) & 1) << 5) | (((lane >> 5) & 1) << 8); }
template <int NCB> __device__ __forceinline__ int v_rd_base2(int lane) { return ((lane & 3) << 3) | (((lane >> 2) & 3) << 6) | (((lane >> 4) & 1) << 5) | (((lane >> 5) & 1) * (NCB * 512)); }
template <int OFF> __device__ __forceinline__ s16x4 tr_read(int vb) { s16x4 r; asm volatile("ds_read_b64_tr_b16 %0, %1 offset:%2" : "=&v"(r) : "v"(vb), "i"(OFF) : "memory"); return r; }
template <int NCB, int D0> __device__ __forceinline__ void pv_one(f32x16& od, int vb, bf16x8 pa0, bf16x8 pa1, bf16x8 pa2, bf16x8 pa3) {
    constexpr int KS = 2 * NCB * 512, HF = NCB * 512, B0 = D0 * 512;
    const s16x4 l0 = tr_read<B0>(vb), h0 = tr_read<B0 + HF>(vb), l1 = tr_read<B0 + KS>(vb), h1 = tr_read<B0 + KS + HF>(vb);
    const s16x4 l2 = tr_read<B0 + 2 * KS>(vb), h2 = tr_read<B0 + 2 * KS + HF>(vb), l3 = tr_read<B0 + 3 * KS>(vb), h3 = tr_read<B0 + 3 * KS + HF>(vb);
    asm volatile("s_waitcnt lgkmcnt(0)" ::: "memory"); __builtin_amdgcn_sched_barrier(0);
#define PK(L, H) (bf16x8){L[0], L[1], L[2], L[3], H[0], H[1], H[2], H[3]}
    od = __builtin_amdgcn_mfma_f32_32x32x16_bf16(pa0, PK(l0, h0), od, 0, 0, 0);
    od = __builtin_amdgcn_mfma_f32_32x32x16_bf16(pa1, PK(l1, h1), od, 0, 0, 0);
    od = __builtin_amdgcn_mfma_f32_32x32x16_bf16(pa2, PK(l2, h2), od, 0, 0, 0);
    od = __builtin_amdgcn_mfma_f32_32x32x16_bf16(pa3, PK(l3, h3), od, 0, 0, 0);
#undef PK
}

struct AttnIO { const bf16_t* Q; int ldq; const bf16_t* K; int ldk; const bf16_t* V; int ldv; bf16_t* O; int ldo; float lam; };

template <int MODE>
__device__ __forceinline__ void attn_unit(char* lds, int wave0, const AttnIO io) {
    using C = ACfg<MODE>;
    constexpr int KW = C::KW, NQK = C::NQK, VW = C::VW, NVB = C::NVB, NRG = C::NRG, NT = C::NT;
    constexpr int KSTR = KW * 2 + 16, KBUF = 64 * KSTR, NCB = VW / 32, VBUF = 64 * VW * 2;
    constexpr int KCPR = KW / 8, KCH = 64 * KCPR, KPASS = (KCH + 511) / 512, VCPR = VW / 8, VCH = 64 * VCPR, VPASS = VCH / 512;
    constexpr int OFF_V = 2 * KBUF, OFF_WS = 2 * KBUF + 2 * VBUF;
    static_assert(OFF_WS + NWAVES * 256 <= LDS_BYTES, "attention LDS");
    int tid_ = wave0 * 64 + lane_id(); asm volatile("" : "+v"(tid_));
    const int tid = tid_, lane = tid & 63, r32 = lane & 31, hi = lane >> 5;
    const int wid = __builtin_amdgcn_readfirstlane(tid >> 6);
    const int rg = wid % NRG, part = wid / NRG;
    char* K_lds = lds; char* V_lds = lds + OFF_V;
    float* wsf = (float*)(lds + OFF_WS) + wid * 64;
    const int qk0 = (MODE == 1) ? 4 * part : 0;
    const int vb0 = (MODE == 2) ? 4 * part : 0;
    bf16x8 qr[NQK];
    {
        const bf16_t* Qw = io.Q + (size_t)(rg * 32 + r32) * io.ldq + ((MODE == 1) ? 64 * part : 0) + hi * 8;
#pragma unroll
        for (int s = 0; s < NQK; ++s) qr[s] = *(const bf16x8*)(Qw + s * 16);
    }
    f32x16 o[NVB];
#pragma unroll
    for (int d = 0; d < NVB; ++d) o[d] = f32x16{};
    float m_reg = -1e30f, l_reg = 0.f;
    bf16x8 ks_[KPASS], vs_[VPASS];
#define A_SLOAD(t) do { const int k0_ = (t) * 64; \
        _Pragma("unroll") for (int i_ = 0; i_ < KPASS; ++i_) { const int id_ = tid + 512 * i_; if (KCH % 512 == 0 || id_ < KCH) ks_[i_] = *(const bf16x8*)(io.K + (size_t)(k0_ + id_ / KCPR) * io.ldk + (id_ % KCPR) * 8); } \
        _Pragma("unroll") for (int i_ = 0; i_ < VPASS; ++i_) { const int id_ = tid + 512 * i_; vs_[i_] = *(const bf16x8*)(io.V + (size_t)(k0_ + id_ / VCPR) * io.ldv + (id_ % VCPR) * 8); } } while (0)
#define A_SWRITE(b) do { \
        _Pragma("unroll") for (int i_ = 0; i_ < KPASS; ++i_) { const int id_ = tid + 512 * i_; if (KCH % 512 == 0 || id_ < KCH) *(bf16x8*)(K_lds + (b) * KBUF + (id_ / KCPR) * KSTR + (id_ % KCPR) * 16) = ks_[i_]; } \
        _Pragma("unroll") for (int i_ = 0; i_ < VPASS; ++i_) { const int id_ = tid + 512 * i_; *(bf16x8*)(V_lds + (b) * VBUF + v_st<NCB>(id_ / VCPR, (id_ % VCPR) * 8)) = vs_[i_]; } } while (0)
    A_SLOAD(0); A_SWRITE(0); __syncthreads();
    const int vbase = (int)(uintptr_t)V_lds + v_rd_base(lane) + vb0 * 512;
    for (int j = 0; j < NT; ++j) {
        const int buf = j & 1;
        if (j + 1 < NT) A_SLOAD(j + 1);
        f32x16 p0 = f32x16{}, p1 = f32x16{};
        {
            const char* kb = K_lds + buf * KBUF + r32 * KSTR + (qk0 * 16 + hi * 8) * 2;
#pragma unroll
            for (int s = 0; s < NQK; ++s) {
                const bf16x8 b0 = *(const bf16x8*)(kb + s * 32);
                const bf16x8 b1 = *(const bf16x8*)(kb + 32 * KSTR + s * 32);
                p0 = __builtin_amdgcn_mfma_f32_32x32x16_bf16(b0, qr[s], p0, 0, 0, 0);
                p1 = __builtin_amdgcn_mfma_f32_32x32x16_bf16(b1, qr[s], p1, 0, 0, 0);
            }
        }
        float pmax = p0[0];
#pragma unroll
        for (int r = 1; r < 16; ++r) pmax = fmaxf(pmax, p0[r]);
#pragma unroll
        for (int r = 0; r < 16; ++r) pmax = fmaxf(pmax, p1[r]);
        { auto rr = __builtin_amdgcn_permlane32_swap(__float_as_uint(pmax), __float_as_uint(pmax), false, false); pmax = fmaxf(__uint_as_float(rr[0]), __uint_as_float(rr[1])); }
        const float mn = fmaxf(m_reg, pmax);
        const float alpha = __builtin_amdgcn_exp2f(m_reg - mn);
        m_reg = mn;
#pragma unroll
        for (int r = 0; r < 16; ++r) { p0[r] = __builtin_amdgcn_exp2f(p0[r] - mn); p1[r] = __builtin_amdgcn_exp2f(p1[r] - mn); }
        float ps = 0.f;
#pragma unroll
        for (int r = 0; r < 16; ++r) ps += p0[r];
#pragma unroll
        for (int r = 0; r < 16; ++r) ps += p1[r];
        { auto rr = __builtin_amdgcn_permlane32_swap(__float_as_uint(ps), __float_as_uint(ps), false, false); ps = __uint_as_float(rr[0]) + __uint_as_float(rr[1]); }
        l_reg = l_reg * alpha + ps;
        bf16x8 pa0, pa1, pa2, pa3;
#define PK4(P, BASE, OUT) do { unsigned a0 = cvt_pk_bf16(P[BASE + 0], P[BASE + 1]), a1 = cvt_pk_bf16(P[BASE + 2], P[BASE + 3]); \
        unsigned b0 = cvt_pk_bf16(P[BASE + 4], P[BASE + 5]), b1 = cvt_pk_bf16(P[BASE + 6], P[BASE + 7]); \
        auto r0 = __builtin_amdgcn_permlane32_swap(a0, b0, false, false); auto r1 = __builtin_amdgcn_permlane32_swap(a1, b1, false, false); \
        u32x4 w = {r0[0], r1[0], r0[1], r1[1]}; OUT = __builtin_bit_cast(bf16x8, w); } while (0)
        PK4(p0, 0, pa0); PK4(p0, 8, pa1); PK4(p1, 0, pa2); PK4(p1, 8, pa3);
#undef PK4
        if (__any(alpha < 1.f)) {
            if (hi == 0) wsf[r32] = alpha;
            asm volatile("s_waitcnt lgkmcnt(0)" ::: "memory");
#pragma unroll
            for (int r = 0; r < 16; ++r) { const float a = wsf[crow(r, hi)];
#pragma unroll
                for (int d = 0; d < NVB; ++d) o[d][r] *= a; }
        }
        {
            const int vb = vbase + buf * VBUF;
            pv_one<NCB, 0>(o[0], vb, pa0, pa1, pa2, pa3);
            pv_one<NCB, 1>(o[1], vb, pa0, pa1, pa2, pa3);
            if constexpr (NVB == 4) { pv_one<NCB, 2>(o[2], vb, pa0, pa1, pa2, pa3); pv_one<NCB, 3>(o[3], vb, pa0, pa1, pa2, pa3); }
        }
        if (j + 1 < NT) A_SWRITE(buf ^ 1);
        __syncthreads();
    }
#undef A_SLOAD
#undef A_SWRITE
    if (hi == 0) wsf[32 + r32] = l_reg;
    asm volatile("s_waitcnt lgkmcnt(0)" ::: "memory");
    float rli[16];
#pragma unroll
    for (int r = 0; r < 16; ++r) rli[r] = 1.0f / wsf[32 + crow(r, hi)];
    if constexpr (MODE == 1) {
        constexpr int XS = 132;
        float* X = (float*)lds;
        if (part == 1) {
#pragma unroll
            for (int r = 0; r < 16; ++r) { const int row = rg * 32 + crow(r, hi);
#pragma unroll
                for (int d = 0; d < NVB; ++d) X[row * XS + d * 32 + r32] = o[d][r] * rli[r]; }
        }
        __syncthreads();
        if (part == 0) {
#pragma unroll
            for (int r = 0; r < 16; ++r) { const int row = rg * 32 + crow(r, hi);
                float ss = 0.f;
#pragma unroll
                for (int d = 0; d < NVB; ++d) { const float t = o[d][r] * rli[r] - io.lam * X[row * XS + d * 32 + r32]; o[d][r] = t; ss += t * t; }
                ss += shx(ss, 1); ss += shx(ss, 2); ss += shx(ss, 4); ss += shx(ss, 8); ss += shx(ss, 16);
                const float rn = __builtin_amdgcn_rsqf(ss * (1.0f / 128) + SUBLN_EPS);
#pragma unroll
                for (int d = 0; d < NVB; ++d) io.O[(size_t)row * io.ldo + d * 32 + r32] = (bf16_t)f2bf(o[d][r] * rn);
            }
        }
        __syncthreads();
    } else {
#pragma unroll
        for (int r = 0; r < 16; ++r) { const int row = rg * 32 + crow(r, hi);
#pragma unroll
            for (int d = 0; d < NVB; ++d) io.O[(size_t)row * io.ldo + (vb0 + d) * 32 + r32] = (bf16_t)f2bf(o[d][r] * rli[r]); }
    }
}

__device__ __forceinline__ float vmax3(float a, float b, float c) { float d; asm("v_max3_f32 %0, %1, %2, %3" : "=v"(d) : "v"(a), "v"(b), "v"(c)); return d; }
__device__ __forceinline__ float vmax2(float a, float b) { float d; asm("v_max_f32 %0, %1, %2" : "=v"(d) : "v"(a), "v"(b)); return d; }
constexpr float ATT_THR = 8.0f;
__device__ __forceinline__ void att_partialSM(f32x16& p0, f32x16& p1, float& m_reg, float& alpha) {
    float pmax = p0[0];
#pragma unroll
    for (int r = 1; r < 16; ++r) pmax = fmaxf(pmax, p0[r]);
#pragma unroll
    for (int r = 0; r < 16; ++r) pmax = fmaxf(pmax, p1[r]);
    { auto rr = __builtin_amdgcn_permlane32_swap(__float_as_uint(pmax), __float_as_uint(pmax), false, false); pmax = fmaxf(__uint_as_float(rr[0]), __uint_as_float(rr[1])); }
    float mn;
    if (__builtin_expect(__all(pmax - m_reg <= ATT_THR), 1)) { mn = m_reg; alpha = 1.f; }
    else { mn = fmaxf(m_reg, pmax); alpha = __builtin_amdgcn_exp2f(m_reg - mn); m_reg = mn; }
#pragma unroll
    for (int r = 0; r < 16; ++r) p0[r] = __builtin_amdgcn_exp2f(p0[r] - mn);
#pragma unroll
    for (int r = 0; r < 16; ++r) p1[r] = p1[r] - mn;
}
__device__ __forceinline__ void att_finishSM(f32x16& p0, f32x16& p1, float alpha, float& l_reg, bf16x8& pa0, bf16x8& pa1, bf16x8& pa2, bf16x8& pa3) {
#pragma unroll
    for (int r = 0; r < 16; ++r) p1[r] = __builtin_amdgcn_exp2f(p1[r]);
    float ps = 0.f;
#pragma unroll
    for (int r = 0; r < 16; ++r) ps += p0[r];
#pragma unroll
    for (int r = 0; r < 16; ++r) ps += p1[r];
    { auto rr = __builtin_amdgcn_permlane32_swap(__float_as_uint(ps), __float_as_uint(ps), false, false); ps = __uint_as_float(rr[0]) + __uint_as_float(rr[1]); }
    l_reg = l_reg * alpha + ps;
#define PK4(P, BASE, OUT) do { unsigned a0 = cvt_pk_bf16(P[BASE + 0], P[BASE + 1]), a1 = cvt_pk_bf16(P[BASE + 2], P[BASE + 3]); \
    unsigned b0 = cvt_pk_bf16(P[BASE + 4], P[BASE + 5]), b1 = cvt_pk_bf16(P[BASE + 6], P[BASE + 7]); \
    auto r0 = __builtin_amdgcn_permlane32_swap(a0, b0, false, false); auto r1 = __builtin_amdgcn_permlane32_swap(a1, b1, false, false); \
    u32x4 w = {r0[0], r1[0], r0[1], r1[1]}; OUT = __builtin_bit_cast(bf16x8, w); } while (0)
    PK4(p0, 0, pa0); PK4(p0, 8, pa1); PK4(p1, 0, pa2); PK4(p1, 8, pa3);
#undef PK4
}
struct VFrag { s16x4 l0, h0, l1, h1, l2, h2, l3, h3; };
template <int NCB, int D> __device__ __forceinline__ void vfrag_read(VFrag& f, int vb) {
    constexpr int KS = 2 * NCB * 512, HF = 256;
    f.l0 = tr_read<D * 512>(vb); f.h0 = tr_read<D * 512 + HF>(vb); f.l1 = tr_read<D * 512 + KS>(vb); f.h1 = tr_read<D * 512 + KS + HF>(vb);
    f.l2 = tr_read<D * 512 + 2 * KS>(vb); f.h2 = tr_read<D * 512 + 2 * KS + HF>(vb); f.l3 = tr_read<D * 512 + 3 * KS>(vb); f.h3 = tr_read<D * 512 + 3 * KS + HF>(vb);
}
__device__ __forceinline__ void att_finishSM2(f32x16& p0, f32x16& p1, float alpha, float& l_reg, bf16x8& pa0, bf16x8& pa1, bf16x8& pa2, bf16x8& pa3) {
#pragma unroll
    for (int r = 0; r < 16; ++r) p1[r] = __builtin_amdgcn_exp2f(p1[r]);
    float ps = 0.f;
#pragma unroll
    for (int r = 0; r < 16; ++r) ps += p0[r];
#pragma unroll
    for (int r = 0; r < 16; ++r) ps += p1[r];
    { auto rr = __builtin_amdgcn_permlane32_swap(__float_as_uint(ps), __float_as_uint(ps), false, false); ps = __uint_as_float(rr[0]) + __uint_as_float(rr[1]); }
    l_reg = l_reg * alpha + ps;
#define PK4N(P, BASE, OUT) do { u32x4 w = {cvt_pk_bf16(P[BASE + 0], P[BASE + 1]), cvt_pk_bf16(P[BASE + 2], P[BASE + 3]), cvt_pk_bf16(P[BASE + 4], P[BASE + 5]), cvt_pk_bf16(P[BASE + 6], P[BASE + 7])}; OUT = __builtin_bit_cast(bf16x8, w); } while (0)
    PK4N(p0, 0, pa0); PK4N(p0, 8, pa1); PK4N(p1, 0, pa2); PK4N(p1, 8, pa3);
#undef PK4N
}
template <int NCB, int NVB> __device__ __forceinline__ void att_pv2(f32x16 (&o)[NVB], int vb, bf16x8 pa0, bf16x8 pa1, bf16x8 pa2, bf16x8 pa3) {
#define PK(L, H) (bf16x8){L[0], L[1], L[2], L[3], H[0], H[1], H[2], H[3]}
    VFrag f;
    vfrag_read<NCB, 0>(f, vb); asm volatile("s_waitcnt lgkmcnt(0)" ::: "memory"); __builtin_amdgcn_sched_barrier(0);
    o[0] = __builtin_amdgcn_mfma_f32_32x32x16_bf16(pa0, PK(f.l0, f.h0), o[0], 0, 0, 0); o[0] = __builtin_amdgcn_mfma_f32_32x32x16_bf16(pa1, PK(f.l1, f.h1), o[0], 0, 0, 0);
    o[0] = __builtin_amdgcn_mfma_f32_32x32x16_bf16(pa2, PK(f.l2, f.h2), o[0], 0, 0, 0); o[0] = __builtin_amdgcn_mfma_f32_32x32x16_bf16(pa3, PK(f.l3, f.h3), o[0], 0, 0, 0);
    vfrag_read<NCB, 1>(f, vb); asm volatile("s_waitcnt lgkmcnt(0)" ::: "memory"); __builtin_amdgcn_sched_barrier(0);
    o[1] = __builtin_amdgcn_mfma_f32_32x32x16_bf16(pa0, PK(f.l0, f.h0), o[1], 0, 0, 0); o[1] = __builtin_amdgcn_mfma_f32_32x32x16_bf16(pa1, PK(f.l1, f.h1), o[1], 0, 0, 0);
    o[1] = __builtin_amdgcn_mfma_f32_32x32x16_bf16(pa2, PK(f.l2, f.h2), o[1], 0, 0, 0); o[1] = __builtin_amdgcn_mfma_f32_32x32x16_bf16(pa3, PK(f.l3, f.h3), o[1], 0, 0, 0);
    if constexpr (NVB == 4) {
        vfrag_read<NCB, 2>(f, vb); asm volatile("s_waitcnt lgkmcnt(0)" ::: "memory"); __builtin_amdgcn_sched_barrier(0);
        o[2] = __builtin_amdgcn_mfma_f32_32x32x16_bf16(pa0, PK(f.l0, f.h0), o[2], 0, 0, 0); o[2] = __builtin_amdgcn_mfma_f32_32x32x16_bf16(pa1, PK(f.l1, f.h1), o[2], 0, 0, 0);
        o[2] = __builtin_amdgcn_mfma_f32_32x32x16_bf16(pa2, PK(f.l2, f.h2), o[2], 0, 0, 0); o[2] = __builtin_amdgcn_mfma_f32_32x32x16_bf16(pa3, PK(f.l3, f.h3), o[2], 0, 0, 0);
        vfrag_read<NCB, 3>(f, vb); asm volatile("s_waitcnt lgkmcnt(0)" ::: "memory"); __builtin_amdgcn_sched_barrier(0);
        o[3] = __builtin_amdgcn_mfma_f32_32x32x16_bf16(pa0, PK(f.l0, f.h0), o[3], 0, 0, 0); o[3] = __builtin_amdgcn_mfma_f32_32x32x16_bf16(pa1, PK(f.l1, f.h1), o[3], 0, 0, 0);
        o[3] = __builtin_amdgcn_mfma_f32_32x32x16_bf16(pa2, PK(f.l2, f.h2), o[3], 0, 0, 0); o[3] = __builtin_amdgcn_mfma_f32_32x32x16_bf16(pa3, PK(f.l3, f.h3), o[3], 0, 0, 0);
    }
#undef PK
}
template <int NQK, int KSTR> __device__ __forceinline__ void att_qkt(f32x16& p0, f32x16& p1, const char* kb, const bf16x8 (&qr)[NQK]) {
    p0 = f32x16{}; p1 = f32x16{};
#pragma unroll
    for (int s = 0; s < NQK; ++s) {
        const bf16x8 b0 = *(const bf16x8*)(kb + s * 32);
        const bf16x8 b1 = *(const bf16x8*)(kb + 32 * KSTR + s * 32);
        p0 = __builtin_amdgcn_mfma_f32_32x32x16_bf16(b0, qr[s], p0, 0, 0, 0);
        p1 = __builtin_amdgcn_mfma_f32_32x32x16_bf16(b1, qr[s], p1, 0, 0, 0);
    }
}
template <int NCB, int NVB> __device__ __forceinline__ void att_pv(f32x16 (&o)[NVB], int vb, bf16x8 pa0, bf16x8 pa1, bf16x8 pa2, bf16x8 pa3) {
    pv_one<NCB, 0>(o[0], vb, pa0, pa1, pa2, pa3);
    pv_one<NCB, 1>(o[1], vb, pa0, pa1, pa2, pa3);
    if constexpr (NVB == 4) { pv_one<NCB, 2>(o[2], vb, pa0, pa1, pa2, pa3); pv_one<NCB, 3>(o[3], vb, pa0, pa1, pa2, pa3); }
}

template <int NCB, int NVB> __device__ __forceinline__ void att_pv_sm(f32x16 (&o)[NVB], int vb, bf16x8 pa0, bf16x8 pa1, bf16x8 pa2, bf16x8 pa3,
                                                                        f32x16& p0, f32x16& p1, float& m_reg, float& alpha) {
#define SB() __builtin_amdgcn_sched_barrier(0)
#define LW() do { asm volatile("s_waitcnt lgkmcnt(0)" ::: "memory"); SB(); } while (0)
#define PK(L, H) (bf16x8){L[0], L[1], L[2], L[3], H[0], H[1], H[2], H[3]}
#define MX8(q) fmaxf(fmaxf(fmaxf(p0[4 * (q)], p0[4 * (q) + 1]), fmaxf(p0[4 * (q) + 2], p0[4 * (q) + 3])), fmaxf(fmaxf(p1[4 * (q)], p1[4 * (q) + 1]), fmaxf(p1[4 * (q) + 2], p1[4 * (q) + 3])))
#define EX4(P, b) do { P[(b)] = __builtin_amdgcn_exp2f(P[(b)] - mn); P[(b) + 1] = __builtin_amdgcn_exp2f(P[(b) + 1] - mn); P[(b) + 2] = __builtin_amdgcn_exp2f(P[(b) + 2] - mn); P[(b) + 3] = __builtin_amdgcn_exp2f(P[(b) + 3] - mn); asm volatile("" : "+v"(P)); } while (0)
#define SU4(P, b) do { P[(b)] -= mn; P[(b) + 1] -= mn; P[(b) + 2] -= mn; P[(b) + 3] -= mn; asm volatile("" : "+v"(P)); } while (0)
    float mn;
    VFrag fa, fb;
    vfrag_read<NCB, 0>(fa, vb);
    LW(); vfrag_read<NCB, 1>(fb, vb); SB();
    {
        o[0] = __builtin_amdgcn_mfma_f32_32x32x16_bf16(pa0, PK(fa.l0, fa.h0), o[0], 0, 0, 0); SB();
        float m0 = MX8(0); asm volatile("" : "+v"(m0)); SB();
        o[0] = __builtin_amdgcn_mfma_f32_32x32x16_bf16(pa1, PK(fa.l1, fa.h1), o[0], 0, 0, 0); SB();
        float m1 = MX8(1); asm volatile("" : "+v"(m1)); SB();
        o[0] = __builtin_amdgcn_mfma_f32_32x32x16_bf16(pa2, PK(fa.l2, fa.h2), o[0], 0, 0, 0); SB();
        float m2 = MX8(2); asm volatile("" : "+v"(m2)); SB();
        o[0] = __builtin_amdgcn_mfma_f32_32x32x16_bf16(pa3, PK(fa.l3, fa.h3), o[0], 0, 0, 0); SB();
        float m3 = MX8(3);
        float pmax = fmaxf(fmaxf(m0, m1), fmaxf(m2, m3));
        { auto rr = __builtin_amdgcn_permlane32_swap(__float_as_uint(pmax), __float_as_uint(pmax), false, false); pmax = fmaxf(__uint_as_float(rr[0]), __uint_as_float(rr[1])); }
        mn = (pmax - m_reg > ATT_THR) ? pmax : m_reg;
        alpha = __builtin_amdgcn_exp2f(m_reg - mn);
        m_reg = mn; asm volatile("" : "+v"(mn), "+v"(alpha)); SB();
    }
    LW(); if constexpr (NVB == 4) vfrag_read<NCB, 2>(fa, vb); SB();
    {
        o[1] = __builtin_amdgcn_mfma_f32_32x32x16_bf16(pa0, PK(fb.l0, fb.h0), o[1], 0, 0, 0); SB();
        EX4(p0, 0); SB();
        o[1] = __builtin_amdgcn_mfma_f32_32x32x16_bf16(pa1, PK(fb.l1, fb.h1), o[1], 0, 0, 0); SB();
        EX4(p0, 4); SB();
        o[1] = __builtin_amdgcn_mfma_f32_32x32x16_bf16(pa2, PK(fb.l2, fb.h2), o[1], 0, 0, 0); SB();
        EX4(p0, 8); SB();
        o[1] = __builtin_amdgcn_mfma_f32_32x32x16_bf16(pa3, PK(fb.l3, fb.h3), o[1], 0, 0, 0); SB();
        EX4(p0, 12); SB();
        if constexpr (NVB == 2) { SU4(p1, 0); SU4(p1, 4); SU4(p1, 8); SU4(p1, 12); SB(); }
    }
    if constexpr (NVB == 4) {
        LW(); vfrag_read<NCB, 3>(fb, vb); SB();
        {
            o[2] = __builtin_amdgcn_mfma_f32_32x32x16_bf16(pa0, PK(fa.l0, fa.h0), o[2], 0, 0, 0); SB();
            SU4(p1, 0); SU4(p1, 4); SB();
            o[2] = __builtin_amdgcn_mfma_f32_32x32x16_bf16(pa1, PK(fa.l1, fa.h1), o[2], 0, 0, 0); SB();
            SU4(p1, 8); SU4(p1, 12); SB();
            o[2] = __builtin_amdgcn_mfma_f32_32x32x16_bf16(pa2, PK(fa.l2, fa.h2), o[2], 0, 0, 0); SB();
            o[2] = __builtin_amdgcn_mfma_f32_32x32x16_bf16(pa3, PK(fa.l3, fa.h3), o[2], 0, 0, 0); SB();
        }
        LW();
        {
            o[3] = __builtin_amdgcn_mfma_f32_32x32x16_bf16(pa0, PK(fb.l0, fb.h0), o[3], 0, 0, 0);
            o[3] = __builtin_amdgcn_mfma_f32_32x32x16_bf16(pa1, PK(fb.l1, fb.h1), o[3], 0, 0, 0);
            o[3] = __builtin_amdgcn_mfma_f32_32x32x16_bf16(pa2, PK(fb.l2, fb.h2), o[3], 0, 0, 0);
            o[3] = __builtin_amdgcn_mfma_f32_32x32x16_bf16(pa3, PK(fb.l3, fb.h3), o[3], 0, 0, 0); SB();
        }
    }
#undef SB
#undef LW
#undef PK
#undef MX8
#undef EX4
#undef SU4
}

template <int NCB, int NVB> __device__ __forceinline__ void att_pv_sm_rel(f32x16 (&o)[NVB], int vb, bf16x8 pa0, bf16x8 pa1, bf16x8 pa2, bf16x8 pa3,
                                                                        f32x16& p0, f32x16& p1, float& m_reg, float& alpha, f32x16& negm) {
#define SB() __builtin_amdgcn_sched_barrier(0)
#define LW() do { asm volatile("s_waitcnt lgkmcnt(0)" ::: "memory"); SB(); } while (0)
#define PK(L, H) (bf16x8){L[0], L[1], L[2], L[3], H[0], H[1], H[2], H[3]}
#define MX8(q) 0
#define EX4(P, b) do { P[(b)] = __builtin_amdgcn_exp2f(P[(b)]); P[(b) + 1] = __builtin_amdgcn_exp2f(P[(b) + 1]); P[(b) + 2] = __builtin_amdgcn_exp2f(P[(b) + 2]); P[(b) + 3] = __builtin_amdgcn_exp2f(P[(b) + 3]); asm volatile("" : "+v"(P)); } while (0)
#define SU4(P, b) do { } while (0)
    float mn;
    VFrag fa, fb;
    vfrag_read<NCB, 0>(fa, vb);
    LW(); vfrag_read<NCB, 1>(fb, vb); SB();
    {
        o[0] = __builtin_amdgcn_mfma_f32_32x32x16_bf16(pa0, PK(fa.l0, fa.h0), o[0], 0, 0, 0); SB();
        float mx;
        asm("v_max3_f32 %0, %1, %2, %3\n\tv_max3_f32 %0, %0, %4, %5\n\tv_max3_f32 %0, %0, %6, %7\n\tv_max3_f32 %0, %0, %8, %9"
            : "=&v"(mx) : "v"(p0[0]), "v"(p0[1]), "v"(p0[2]), "v"(p0[3]), "v"(p1[0]), "v"(p1[1]), "v"(p1[2]), "v"(p1[3]), "v"(p0[4])); SB();
        o[0] = __builtin_amdgcn_mfma_f32_32x32x16_bf16(pa1, PK(fa.l1, fa.h1), o[0], 0, 0, 0); SB();
        asm("v_max3_f32 %0, %0, %1, %2\n\tv_max3_f32 %0, %0, %3, %4\n\tv_max3_f32 %0, %0, %5, %6\n\tv_max3_f32 %0, %0, %7, %8"
            : "+v"(mx) : "v"(p0[5]), "v"(p0[6]), "v"(p0[7]), "v"(p1[4]), "v"(p1[5]), "v"(p1[6]), "v"(p1[7]), "v"(p0[8])); SB();
        o[0] = __builtin_amdgcn_mfma_f32_32x32x16_bf16(pa2, PK(fa.l2, fa.h2), o[0], 0, 0, 0); SB();
        asm("v_max3_f32 %0, %0, %1, %2\n\tv_max3_f32 %0, %0, %3, %4\n\tv_max3_f32 %0, %0, %5, %6\n\tv_max3_f32 %0, %0, %7, %8"
            : "+v"(mx) : "v"(p0[9]), "v"(p0[10]), "v"(p0[11]), "v"(p1[8]), "v"(p1[9]), "v"(p1[10]), "v"(p1[11]), "v"(p0[12])); SB();
        o[0] = __builtin_amdgcn_mfma_f32_32x32x16_bf16(pa3, PK(fa.l3, fa.h3), o[0], 0, 0, 0); SB();
        asm("v_max3_f32 %0, %0, %1, %2\n\tv_max3_f32 %0, %0, %3, %4\n\tv_max3_f32 %0, %0, %5, %6\n\tv_max_f32 %0, %0, %7\n\ts_nop 1"
            : "+v"(mx) : "v"(p0[13]), "v"(p0[14]), "v"(p0[15]), "v"(p1[12]), "v"(p1[13]), "v"(p1[14]), "v"(p1[15]));
        float pmax = mx;
        { auto rr = __builtin_amdgcn_permlane32_swap(__float_as_uint(pmax), __float_as_uint(pmax), false, false); pmax = vmax2(__uint_as_float(rr[0]), __uint_as_float(rr[1])); }
        alpha = 1.f;
        if (__any(pmax > ATT_THR)) {
            const float delta = pmax > ATT_THR ? pmax : 0.f;
            alpha = __builtin_amdgcn_exp2f(-delta);
#pragma unroll
            for (int r = 0; r < 16; ++r) { p0[r] -= delta; p1[r] -= delta; }
            m_reg += delta;
#pragma unroll
            for (int r = 0; r < 16; ++r) negm[r] = -m_reg;
        }
        mn = 0.f; asm volatile("" : "+v"(alpha)); SB();
    }
    LW(); if constexpr (NVB == 4) vfrag_read<NCB, 2>(fa, vb); SB();
    {
        o[1] = __builtin_amdgcn_mfma_f32_32x32x16_bf16(pa0, PK(fb.l0, fb.h0), o[1], 0, 0, 0); SB();
        EX4(p0, 0); SB();
        o[1] = __builtin_amdgcn_mfma_f32_32x32x16_bf16(pa1, PK(fb.l1, fb.h1), o[1], 0, 0, 0); SB();
        EX4(p0, 4); SB();
        o[1] = __builtin_amdgcn_mfma_f32_32x32x16_bf16(pa2, PK(fb.l2, fb.h2), o[1], 0, 0, 0); SB();
        EX4(p0, 8); SB();
        o[1] = __builtin_amdgcn_mfma_f32_32x32x16_bf16(pa3, PK(fb.l3, fb.h3), o[1], 0, 0, 0); SB();
        EX4(p0, 12); SB();
        if constexpr (NVB == 2) { SU4(p1, 0); SU4(p1, 4); SU4(p1, 8); SU4(p1, 12); SB(); }
    }
    if constexpr (NVB == 4) {
        LW(); vfrag_read<NCB, 3>(fb, vb); SB();
        {
            o[2] = __builtin_amdgcn_mfma_f32_32x32x16_bf16(pa0, PK(fa.l0, fa.h0), o[2], 0, 0, 0); SB();
            SU4(p1, 0); SU4(p1, 4); SB();
            o[2] = __builtin_amdgcn_mfma_f32_32x32x16_bf16(pa1, PK(fa.l1, fa.h1), o[2], 0, 0, 0); SB();
            SU4(p1, 8); SU4(p1, 12); SB();
            o[2] = __builtin_amdgcn_mfma_f32_32x32x16_bf16(pa2, PK(fa.l2, fa.h2), o[2], 0, 0, 0); SB();
            o[2] = __builtin_amdgcn_mfma_f32_32x32x16_bf16(pa3, PK(fa.l3, fa.h3), o[2], 0, 0, 0); SB();
        }
        LW();
        {
            o[3] = __builtin_amdgcn_mfma_f32_32x32x16_bf16(pa0, PK(fb.l0, fb.h0), o[3], 0, 0, 0);
            o[3] = __builtin_amdgcn_mfma_f32_32x32x16_bf16(pa1, PK(fb.l1, fb.h1), o[3], 0, 0, 0);
            o[3] = __builtin_amdgcn_mfma_f32_32x32x16_bf16(pa2, PK(fb.l2, fb.h2), o[3], 0, 0, 0);
            o[3] = __builtin_amdgcn_mfma_f32_32x32x16_bf16(pa3, PK(fb.l3, fb.h3), o[3], 0, 0, 0); SB();
        }
    }
#undef SB
#undef LW
#undef PK
#undef MX8
#undef EX4
#undef SU4
}

template <int MODE>
__device__ __forceinline__ void attn_unit_p(char* lds, int wave0, const AttnIO io) {
    using C = ACfg<MODE>;
    static_assert(MODE == 0 || MODE == 1, "pipelined body: MLA and differential attention");
    constexpr int KW = C::KW, NQK = C::NQK, VW = C::VW, NVB = C::NVB, NRG = C::NRG, NT = C::NT;
    constexpr int KSTR = KW * 2 + 16, KBUF = 64 * KSTR, NCB = VW / 32, VBUF = 64 * VW * 2;
    constexpr int KCPR = KW / 8, KCH = 64 * KCPR, KPASS = (KCH + 511) / 512, VCPR = VW / 8, VCH = 64 * VCPR, VPASS = VCH / 512;
    constexpr int OFF_V = 2 * KBUF, OFF_WS = 2 * KBUF + 2 * VBUF;
    static_assert(NT % 2 == 0 && NT >= 4, "even tile count");
    int tid_ = wave0 * 64 + lane_id(); asm volatile("" : "+v"(tid_));
    const int tid = tid_, lane = tid & 63, r32 = lane & 31, hi = lane >> 5;
    const int wid = __builtin_amdgcn_readfirstlane(tid >> 6);
    const int rg = wid % NRG, part = wid / NRG;
    char* K_lds = lds; char* V_lds = lds + OFF_V;
    float* wsf = (float*)(lds + OFF_WS) + wid * 64;
    const int qk0 = (MODE == 1) ? 4 * part : 0;
    bf16x8 qr[NQK];
    {
        const bf16_t* Qw = io.Q + (size_t)(rg * 32 + r32) * io.ldq + ((MODE == 1) ? 64 * part : 0) + hi * 8;
#pragma unroll
        for (int s = 0; s < NQK; ++s) qr[s] = *(const bf16x8*)(Qw + s * 16);
    }
    f32x16 o[NVB];
#pragma unroll
    for (int d = 0; d < NVB; ++d) o[d] = f32x16{};
    float m_reg = -1e30f, l_reg = 0.f;
    struct { bf16x8 k[KPASS]; bf16x8 v[VPASS]; } sr_[2];
    constexpr int SE = 0, SO = 1;
#define P_SLOAD(S, t) do { const int k0_ = (t) * 64; \
        _Pragma("unroll") for (int i_ = 0; i_ < KPASS; ++i_) { const int id_ = tid + 512 * i_; if (KCH % 512 == 0 || id_ < KCH) sr_[S].k[i_] = *(const bf16x8*)(io.K + (size_t)(k0_ + id_ / KCPR) * io.ldk + (id_ % KCPR) * 8); } \
        _Pragma("unroll") for (int i_ = 0; i_ < VPASS; ++i_) { const int id_ = tid + 512 * i_; sr_[S].v[i_] = *(const bf16x8*)(io.V + (size_t)(k0_ + id_ / VCPR) * io.ldv + (id_ % VCPR) * 8); } } while (0)
#define P_SWRITE(b, S) do { \
        _Pragma("unroll") for (int i_ = 0; i_ < KPASS; ++i_) { const int id_ = tid + 512 * i_; if (KCH % 512 == 0 || id_ < KCH) *(bf16x8*)(K_lds + (b) * KBUF + (id_ / KCPR) * KSTR + (id_ % KCPR) * 16) = sr_[S].k[i_]; } \
        _Pragma("unroll") for (int i_ = 0; i_ < VPASS; ++i_) { const int id_ = tid + 512 * i_; *(bf16x8*)(V_lds + (b) * VBUF + v_st<NCB>(id_ / VCPR, (id_ % VCPR) * 8)) = sr_[S].v[i_]; } } while (0)
#define P_SWAIT() asm volatile("s_waitcnt vmcnt(%0)" :: "n"(VPASS + KCH / 512) : "memory")
#define P_RESC(a) do { if (__any((a) < 1.f)) { if (hi == 0) wsf[r32] = (a); asm volatile("s_waitcnt lgkmcnt(0)" ::: "memory"); \
        _Pragma("unroll") for (int r = 0; r < 16; ++r) { const float a_ = wsf[crow(r, hi)]; _Pragma("unroll") for (int d = 0; d < NVB; ++d) o[d][r] *= a_; } } } while (0)
#define P_SBAR() __builtin_amdgcn_sched_barrier(0)
    const char* kb0 = K_lds + r32 * KSTR + (qk0 * 16 + hi * 8) * 2;
    const int vbase = (int)(uintptr_t)V_lds + v_rd_base(lane);
    f32x16 pA0, pA1, pB0, pB1; float alA, alB; bf16x8 pa0, pa1, pa2, pa3;
    P_SLOAD(SE, 0); asm volatile("s_waitcnt vmcnt(0)" ::: "memory"); P_SWRITE(0, SE); __syncthreads();
    att_qkt<NQK, KSTR>(pA0, pA1, kb0, qr); att_partialSM(pA0, pA1, m_reg, alA);
    P_SLOAD(SO, 1); P_SLOAD(SE, 2);
    P_SWAIT(); P_SWRITE(1, SO); __syncthreads();
    for (int j = 1; j + 1 < NT; j += 2) {
        P_SBAR(); att_qkt<NQK, KSTR>(pB0, pB1, kb0 + KBUF, qr);
        att_finishSM(pA0, pA1, alA, l_reg, pa0, pa1, pa2, pa3); P_SBAR();
        P_SLOAD(SO, j + 2); P_SBAR();
        att_pv_sm<NCB, NVB>(o, vbase, pa0, pa1, pa2, pa3, pB0, pB1, m_reg, alB);
        __syncthreads(); P_SWAIT(); P_SWRITE(0, SE);
        P_RESC(alB); __syncthreads();
        P_SBAR(); att_qkt<NQK, KSTR>(pA0, pA1, kb0, qr);
        att_finishSM(pB0, pB1, alB, l_reg, pa0, pa1, pa2, pa3); P_SBAR();
        if (j + 3 < NT) P_SLOAD(SE, j + 3); P_SBAR();
        att_pv_sm<NCB, NVB>(o, vbase + VBUF, pa0, pa1, pa2, pa3, pA0, pA1, m_reg, alA);
        __syncthreads(); P_SWAIT(); P_SWRITE(1, SO);
        P_RESC(alA); __syncthreads();
    }
    P_SBAR(); att_qkt<NQK, KSTR>(pB0, pB1, kb0 + KBUF, qr);
    att_finishSM(pA0, pA1, alA, l_reg, pa0, pa1, pa2, pa3); P_SBAR();
    att_pv_sm<NCB, NVB>(o, vbase, pa0, pa1, pa2, pa3, pB0, pB1, m_reg, alB);
    __syncthreads(); P_RESC(alB);
    att_finishSM(pB0, pB1, alB, l_reg, pa0, pa1, pa2, pa3); P_SBAR();
    att_pv<NCB, NVB>(o, vbase + VBUF, pa0, pa1, pa2, pa3);
#undef P_SLOAD
#undef P_SWRITE
#undef P_SWAIT
#undef P_RESC
#undef P_SBAR
    __syncthreads();
    if (hi == 0) wsf[32 + r32] = l_reg;
    asm volatile("s_waitcnt lgkmcnt(0)" ::: "memory");
    float rli[16];
#pragma unroll
    for (int r = 0; r < 16; ++r) rli[r] = 1.0f / wsf[32 + crow(r, hi)];
    if constexpr (MODE == 1) {
        constexpr int XS = 132;
        float* X = (float*)lds;
        if (part == 1) {
#pragma unroll
            for (int r = 0; r < 16; ++r) { const int row = rg * 32 + crow(r, hi);
#pragma unroll
                for (int d = 0; d < NVB; ++d) X[row * XS + d * 32 + r32] = o[d][r] * rli[r]; }
        }
        __syncthreads();
        if (part == 0) {
#pragma unroll
            for (int r = 0; r < 16; ++r) { const int row = rg * 32 + crow(r, hi);
                float ss = 0.f;
#pragma unroll
                for (int d = 0; d < NVB; ++d) { const float t = o[d][r] * rli[r] - io.lam * X[row * XS + d * 32 + r32]; o[d][r] = t; ss += t * t; }
                ss += shx(ss, 1); ss += shx(ss, 2); ss += shx(ss, 4); ss += shx(ss, 8); ss += shx(ss, 16);
                const float rn = __builtin_amdgcn_rsqf(ss * (1.0f / 128) + SUBLN_EPS);
#pragma unroll
                for (int d = 0; d < NVB; ++d) io.O[(size_t)row * io.ldo + d * 32 + r32] = (bf16_t)f2bf(o[d][r] * rn);
            }
        }
        __syncthreads();
    } else {
#pragma unroll
        for (int r = 0; r < 16; ++r) { const int row = rg * 32 + crow(r, hi);
#pragma unroll
            for (int d = 0; d < NVB; ++d) io.O[(size_t)row * io.ldo + d * 32 + r32] = (bf16_t)f2bf(o[d][r] * rli[r]); }
    }
}

__device__ __forceinline__ void glds16(const void* gsrc, unsigned lds_dst) {
    unsigned keep;
    asm volatile("s_mov_b32 %0, m0\n\ts_mov_b32 m0, %2\n\ts_nop 0\n\tglobal_load_lds_dwordx4 %1, off\n\ts_mov_b32 m0, %0" : "=&s"(keep) : "v"(gsrc), "s"(lds_dst) : "memory");
}
template <int CPR> __device__ __forceinline__ int kswz(int r) { return CPR == 16 ? (r & 15) : (r & 3); }
template <int NQK, int CPR> __device__ __forceinline__ void att_qkt_d(f32x16& p0, f32x16& p1, const char* kslot, int r32, int hi, int qk0, const bf16x8 (&qr)[NQK], const f32x16& cin) {
    p0 = cin; p1 = cin;
    const char* r0 = kslot + r32 * (CPR * 16); const char* r1 = kslot + (32 + r32) * (CPR * 16);
    const int f0 = kswz<CPR>(r32), f1 = kswz<CPR>(32 + r32);
#pragma unroll
    for (int s = 0; s < NQK; ++s) {
        const int c = 2 * (qk0 + s) + hi;
        const bf16x8 b0 = *(const bf16x8*)(r0 + ((c ^ f0) << 4));
        const bf16x8 b1 = *(const bf16x8*)(r1 + ((c ^ f1) << 4));
        p0 = __builtin_amdgcn_mfma_f32_32x32x16_bf16(b0, qr[s], p0, 0, 0, 0);
        p1 = __builtin_amdgcn_mfma_f32_32x32x16_bf16(b1, qr[s], p1, 0, 0, 0);
    }
}
template <int MODE>
__device__ __forceinline__ void attn_unit_d(char* lds, int wave0, const AttnIO io) {
    using C = ACfg<MODE>;
    static_assert(MODE == 0 || MODE == 1, "LDS-DMA body: MLA and differential attention");
    constexpr int KW = C::KW, NQK = C::NQK, VW = C::VW, NVB = C::NVB, NRG = C::NRG, NT = C::NT;
    constexpr int CPR = KW / 8, KT = 64 * KW * 2, NCB = VW / 32, VT = 64 * VW * 2;
    constexpr int KI = KT / 1024, VI = VT / 1024;
    constexpr int KPW = (KI + 7) / 8, VPW = VI / 8;
    constexpr int OFF_V = 3 * KT, OFF_WS = 3 * KT + 3 * VT;
    static_assert(NT % 2 == 0 && NT >= 4 && OFF_WS + NWAVES * 256 <= LDS_BYTES - 64, "ring geometry");
    int tid_ = wave0 * 64 + lane_id(); asm volatile("" : "+v"(tid_));
    const int tid = tid_, lane = tid & 63, r32 = lane & 31, hi = lane >> 5;
    const int wid = __builtin_amdgcn_readfirstlane(tid >> 6);
    const int rg = wid % NRG, part = wid / NRG;
    float* wsf = (float*)(lds + OFF_WS) + wid * 64;
    const int qk0 = (MODE == 1) ? 4 * part : 0;
    const unsigned lds0 = (unsigned)(uintptr_t)lds;
    int ksrc[KPW], vsrc[VPW];
#pragma unroll
    for (int i = 0; i < KPW; ++i) { const int g = 64 * (wid + 8 * i) + lane, r = g / CPR, p = g % CPR; ksrc[i] = r * io.ldk + ((p ^ kswz<CPR>(r)) << 3); }
#pragma unroll
    for (int i = 0; i < VPW; ++i) { const int q = wid + 8 * i, st = 2 * q + (lane >> 5), kk = (st / NCB) * 8 + ((lane & 31) >> 2), k = (kk & ~0xC) | ((kk & 4) << 1) | ((kk & 8) >> 1);
        vsrc[i] = k * io.ldv + (st % NCB) * 32 + 8 * (lane & 3); }
    const bool k2 = (wid + 8 * (KPW - 1)) < KI;
#define D_DMA_K(t) do { const bf16_t* kt_ = io.K + (size_t)(t) * 64 * io.ldk; const unsigned sl_ = lds0 + ((t) % 3) * KT; \
        _Pragma("unroll") for (int i_ = 0; i_ < KPW; ++i_) if (i_ < KPW - 1 || k2) glds16(kt_ + ksrc[i_], (unsigned)__builtin_amdgcn_readfirstlane(sl_ + (wid + 8 * i_) * 1024)); } while (0)
#define D_DMA_V(t) do { const bf16_t* vt_ = io.V + (size_t)(t) * 64 * io.ldv; const unsigned sl_ = lds0 + OFF_V + ((t) % 3) * VT; \
        _Pragma("unroll") for (int i_ = 0; i_ < VPW; ++i_) glds16(vt_ + vsrc[i_], (unsigned)__builtin_amdgcn_readfirstlane(sl_ + (wid + 8 * i_) * 1024)); } while (0)
#define D_CLOSE_FLY() do { if (KPW == 2 && VPW == 2) asm volatile("s_waitcnt vmcnt(4) lgkmcnt(0)\n\ts_barrier" ::: "memory"); \
        else if (k2) asm volatile("s_waitcnt vmcnt(3) lgkmcnt(0)\n\ts_barrier" ::: "memory"); else asm volatile("s_waitcnt vmcnt(2) lgkmcnt(0)\n\ts_barrier" ::: "memory"); } while (0)
#define D_CLOSE_ALL() asm volatile("s_waitcnt vmcnt(0) lgkmcnt(0)\n\ts_barrier" ::: "memory")
#define D_RESC(a) do { if (__any((a) < 1.f)) { if (hi == 0) wsf[r32] = (a); asm volatile("s_waitcnt lgkmcnt(0)" ::: "memory"); \
        _Pragma("unroll") for (int r = 0; r < 16; ++r) { const float a_ = wsf[crow(r, hi)]; _Pragma("unroll") for (int d = 0; d < NVB; ++d) o[d][r] *= a_; } } } while (0)
#define D_SBAR() __builtin_amdgcn_sched_barrier(0)
    D_DMA_K(0); D_DMA_V(0); D_DMA_K(1);
    bf16x8 qr[NQK];
    {
        const bf16_t* Qw = io.Q + (size_t)(rg * 32 + r32) * io.ldq + ((MODE == 1) ? 64 * part : 0) + hi * 8;
#pragma unroll
        for (int s = 0; s < NQK; ++s) qr[s] = *(const bf16x8*)(Qw + s * 16);
    }
    f32x16 o[NVB];
#pragma unroll
    for (int d = 0; d < NVB; ++d) o[d] = f32x16{};
    float m_reg = -1e30f, l_reg = 0.f;
    const int vbase = (int)lds0 + OFF_V + v_rd_base2<NCB>(lane);
    f32x16 pA0, pA1, pB0, pB1; float alA, alB; bf16x8 pa0, pa1, pa2, pa3;
    D_CLOSE_ALL();
    D_DMA_K(2); D_DMA_V(1);
    f32x16 negm = f32x16{};
    att_qkt_d<NQK, CPR>(pA0, pA1, lds, r32, hi, qk0, qr, negm); att_partialSM(pA0, pA1, m_reg, alA);
#pragma unroll
    for (int r = 0; r < 16; ++r) negm[r] = -m_reg;
    D_CLOSE_FLY();
    for (int s = 1; s + 1 < NT; s += 2) {
        if (s + 2 < NT) D_DMA_K(s + 2);
        D_DMA_V(s + 1);
        D_SBAR(); __builtin_amdgcn_s_setprio(1); att_qkt_d<NQK, CPR>(pB0, pB1, lds + (s % 3) * KT, r32, hi, qk0, qr, negm);
        att_finishSM2(pA0, pA1, alA, l_reg, pa0, pa1, pa2, pa3); D_SBAR();
        att_pv_sm_rel<NCB, NVB>(o, vbase + ((s - 1) % 3) * VT, pa0, pa1, pa2, pa3, pB0, pB1, m_reg, alB, negm);
        __builtin_amdgcn_s_setprio(0); D_RESC(alB);
        if (s + 2 < NT) D_CLOSE_FLY(); else D_CLOSE_ALL();
        if (s + 3 < NT) D_DMA_K(s + 3);
        if (s + 2 < NT) D_DMA_V(s + 2);
        D_SBAR(); __builtin_amdgcn_s_setprio(1); att_qkt_d<NQK, CPR>(pA0, pA1, lds + ((s + 1) % 3) * KT, r32, hi, qk0, qr, negm);
        att_finishSM2(pB0, pB1, alB, l_reg, pa0, pa1, pa2, pa3); D_SBAR();
        att_pv_sm_rel<NCB, NVB>(o, vbase + (s % 3) * VT, pa0, pa1, pa2, pa3, pA0, pA1, m_reg, alA, negm);
        __builtin_amdgcn_s_setprio(0); D_RESC(alA);
        if (s + 3 < NT) D_CLOSE_FLY(); else D_CLOSE_ALL();
    }
    D_SBAR(); att_qkt_d<NQK, CPR>(pB0, pB1, lds + ((NT - 1) % 3) * KT, r32, hi, qk0, qr, negm);
    att_finishSM2(pA0, pA1, alA, l_reg, pa0, pa1, pa2, pa3); D_SBAR();
    att_pv_sm_rel<NCB, NVB>(o, vbase + ((NT - 2) % 3) * VT, pa0, pa1, pa2, pa3, pB0, pB1, m_reg, alB, negm);
    D_RESC(alB);
    att_finishSM2(pB0, pB1, alB, l_reg, pa0, pa1, pa2, pa3); D_SBAR();
    att_pv2<NCB, NVB>(o, vbase + ((NT - 1) % 3) * VT, pa0, pa1, pa2, pa3);
#undef D_DMA_K
#undef D_DMA_V
#undef D_CLOSE_FLY
#undef D_CLOSE_ALL
#undef D_RESC
#undef D_SBAR
    asm volatile("s_waitcnt vmcnt(0) lgkmcnt(0)\n\ts_barrier" ::: "memory");
    if (hi == 0) wsf[32 + r32] = l_reg;
    asm volatile("s_waitcnt lgkmcnt(0)" ::: "memory");
    float rli[16];
#pragma unroll
    for (int r = 0; r < 16; ++r) rli[r] = __builtin_amdgcn_rcpf(wsf[32 + crow(r, hi)]);
    if constexpr (MODE == 1) {
        constexpr int XS = 132;
        float* X = (float*)lds;
        if (part == 1) {
#pragma unroll
            for (int r = 0; r < 16; ++r) { const int row = rg * 32 + crow(r, hi);
#pragma unroll
                for (int d = 0; d < NVB; ++d) X[row * XS + d * 32 + r32] = o[d][r] * rli[r]; }
        }
        __syncthreads();
        if (part == 0) {
#pragma unroll
            for (int r = 0; r < 16; ++r) { const int row = rg * 32 + crow(r, hi);
#pragma unroll
                for (int d = 0; d < NVB; ++d) { float* xp = X + row * XS + d * 32 + r32; *xp = o[d][r] * rli[r] - io.lam * *xp; } }
            asm volatile("s_waitcnt lgkmcnt(0)" ::: "memory");
#pragma unroll
            for (int i = 0; i < 8; ++i) { const int rw = rg * 32 + i * 4 + (lane >> 4), ch = lane & 15;
                const f32x4 a = *(const f32x4*)(X + rw * XS + ch * 8), b = *(const f32x4*)(X + rw * XS + ch * 8 + 4);
                float ss = ((a.x * a.x + a.y * a.y) + (a.z * a.z + a.w * a.w)) + ((b.x * b.x + b.y * b.y) + (b.z * b.z + b.w * b.w));
                ss += __builtin_bit_cast(float, __builtin_amdgcn_update_dpp(0, __builtin_bit_cast(int, ss), 0xB1, 0xf, 0xf, false));
                ss += __builtin_bit_cast(float, __builtin_amdgcn_update_dpp(0, __builtin_bit_cast(int, ss), 0x4E, 0xf, 0xf, false));
                ss += __builtin_bit_cast(float, __builtin_amdgcn_update_dpp(0, __builtin_bit_cast(int, ss), 0x124, 0xf, 0xf, false));
                ss += __builtin_bit_cast(float, __builtin_amdgcn_update_dpp(0, __builtin_bit_cast(int, ss), 0x128, 0xf, 0xf, false));
                const float rn = __builtin_amdgcn_rsqf(ss * (1.0f / 128) + SUBLN_EPS);
                float v[8] = {a.x * rn, a.y * rn, a.z * rn, a.w * rn, b.x * rn, b.y * rn, b.z * rn, b.w * rn};
                *(u32x4*)(io.O + (size_t)rw * io.ldo + ch * 8) = pack8(v); }
        }
        __syncthreads();
    } else {
        bf16_t* stg = (bf16_t*)lds + wid * (32 * 72);
#pragma unroll
        for (int r = 0; r < 16; ++r) { const int rw = crow(r, hi);
#pragma unroll
            for (int d = 0; d < NVB; ++d) stg[rw * 72 + d * 32 + r32] = (bf16_t)f2bf(o[d][r] * rli[r]); }
        asm volatile("s_waitcnt lgkmcnt(0)" ::: "memory");
#pragma unroll
        for (int i = 0; i < 4; ++i) { const int rw = i * 8 + (lane >> 3), ch = lane & 7;
            const u32x4 v = *(const u32x4*)(stg + rw * 72 + ch * 8);
            *(u32x4*)(io.O + (size_t)(rg * 32 + rw) * io.ldo + ch * 8) = v; }
        asm volatile("s_waitcnt lgkmcnt(0)\n\ts_barrier" ::: "memory");
    }
}

constexpr int HY_ZSE = 2048 + 16;
constexpr int HY_ZBYTES = 16 * HY_ZSE * 2;
constexpr int HY_CSB = 8192 + 64;
__device__ __forceinline__ void hyena_unit(char* lds, int wave0, int c, const bf16_t* HYT, const bf16_t* FILT, const float* conv_w, const float* conv_b, const float* skip, bf16_t* MIX) {
    int tid_ = wave0 * 64 + lane_id(); asm volatile("" : "+v"(tid_));
    const int tid = tid_, lane = tid & 63, i = lane & 15, g = lane >> 4;
    const int wid = __builtin_amdgcn_readfirstlane(tid >> 6), q = wid >> 1, rho = wid & 1;
    bf16_t* Z = (bf16_t*)lds; char* F = lds + HY_ZBYTES;
    {
        const float w0 = conv_w[c], w1 = conv_w[1536 + c], w2 = conv_w[3072 + c], bb = conv_b[c];
        const bf16_t* src = HYT + (size_t)c * T_TOK;
#pragma unroll 2
        for (int k = 0; k < 8; ++k) {
            const int id = tid + 512 * k, b = id >> 8, s0 = (id & 255) * 8;
            const bf16x8 x = *(const bf16x8*)(src + b * SEQ + s0);
            const float pvr = bf2f(src[b * SEQ + s0 + (s0 > 0 ? -1 : 0)]), nxr = bf2f(src[b * SEQ + s0 + (s0 + 8 < SEQ ? 8 : 7)]);
            const float pv = s0 > 0 ? pvr : 0.f, nx = s0 + 8 < SEQ ? nxr : 0.f;
            float e[10]; e[0] = pv; e[9] = nx;
#pragma unroll
            for (int j = 0; j < 8; ++j) e[j + 1] = bf2f((unsigned short)x[j]);
            float r[8];
#pragma unroll
            for (int j = 0; j < 8; ++j) r[j] = w0 * e[j] + w1 * e[j + 1] + w2 * e[j + 2] + bb;
            *(u32x4*)(Z + b * HY_ZSE + s0) = pack8(r);
        }
    }
    for (int ord = 0; ord < 2; ++ord) {
        {
            const bf16_t* R = FILT + (size_t)(ord * 512 + c) * 4096;
#pragma unroll
            for (int k = 0; k < 8; ++k) {
                const int idx = tid + 512 * k; const bf16_t val = R[idx];
#pragma unroll
                for (int m = 0; m < 4; ++m) if (idx >= m) *(bf16_t*)(F + m * HY_CSB + (idx - m) * 2) = val;
            }
        }
        __syncthreads();
        f32x4 acc[16];
#pragma unroll
        for (int a = 0; a < 16; ++a) acc[a] = (f32x4){0.f, 0.f, 0.f, 0.f};
        {
            const int m = (3 - i) & 3, n0 = 2047 - i - m + 8 * g;
            const char* Ab = F + m * HY_CSB + 2 * (n0 - (512 * q + 16 * rho));
            const char* Zb = (const char*)Z + i * (HY_ZSE * 2) + g * 16;
            bf16x8 W[16];
#define HY_LDA(u) ({ const u32x2 lo_ = *(const u32x2*)(Ab - 64 * (u)); const u32x2 hi_ = *(const u32x2*)(Ab - 64 * (u) + 8); u32x4 w_ = {lo_.x, lo_.y, hi_.x, hi_.y}; __builtin_bit_cast(bf16x8, w_); })
#pragma unroll
            for (int u = 0; u < 16; ++u) W[u] = HY_LDA(u);
            bf16x8 Bn = *(const bf16x8*)Zb;
            for (int sb = 0; sb < 64; sb += 16) {
#pragma unroll
                for (int s1 = 0; s1 < 16; ++s1) {
                    const int sg = sb + s1;
                    const bf16x8 B = Bn;
                    bf16x8 Wn = W[15 - s1];
                    if (sg < 63) { Bn = *(const bf16x8*)(Zb + 64 * (sg + 1)); Wn = HY_LDA(-(sg + 1)); }
#pragma unroll
                    for (int a = 0; a < 16; ++a) acc[a] = __builtin_amdgcn_mfma_f32_16x16x32_bf16(W[(a - s1) & 15], B, acc[a], 0, 0, 0);
                    W[15 - s1] = Wn;
                }
            }
#undef HY_LDA
        }
        __syncthreads();
        {
            const int gch = 512 * (ord + 1) + c;
            const float w0 = conv_w[gch], w1 = conv_w[1536 + gch], w2 = conv_w[3072 + gch], bb = conv_b[gch], sk = skip[ord * 512 + c];
            const bf16_t* __restrict__ src = HYT + (size_t)gch * T_TOK + i * SEQ + 512 * q + 16 * rho + 4 * g;
            const int tb = 512 * q + 16 * rho + 4 * g;
            u32x2 xr[16]; unsigned short hp[16], hn[16];
#pragma unroll
            for (int a = 0; a < 16; ++a) {
                const int t = tb + 32 * a;
                xr[a] = *(const u32x2*)(src + 32 * a);
                hp[a] = src[32 * a + (t > 0 ? -1 : 0)]; hn[a] = src[32 * a + (t + 4 < SEQ ? 4 : 3)];
            }
            bf16_t* zt = MIX + (size_t)c * T_TOK + i * SEQ + tb;
#pragma unroll
            for (int a = 0; a < 16; ++a) {
                const int t = tb + 32 * a;
                const float pv = t > 0 ? bf2f(hp[a]) : 0.f, nx = t + 4 < SEQ ? bf2f(hn[a]) : 0.f;
                float e[6]; e[0] = pv; e[1] = bf2f((unsigned short)(xr[a].x & 0xffff)); e[2] = bf2f((unsigned short)(xr[a].x >> 16)); e[3] = bf2f((unsigned short)(xr[a].y & 0xffff)); e[4] = bf2f((unsigned short)(xr[a].y >> 16)); e[5] = nx;
                const u32x2 zo = *(const u32x2*)(Z + i * HY_ZSE + t);
                float zf[4]; zf[0] = bf2f((unsigned short)(zo.x & 0xffff)); zf[1] = bf2f((unsigned short)(zo.x >> 16)); zf[2] = bf2f((unsigned short)(zo.y & 0xffff)); zf[3] = bf2f((unsigned short)(zo.y >> 16));
                float zn[4];
#pragma unroll
                for (int r = 0; r < 4; ++r) { const float gate = w0 * e[r] + w1 * e[r + 1] + w2 * e[r + 2] + bb; zn[r] = gate * (acc[a][r] + sk * zf[r]); }
                if (ord == 0) { u32x2 w; w.x = cvt_pk_bf16(zn[0], zn[1]); w.y = cvt_pk_bf16(zn[2], zn[3]); *(u32x2*)(Z + i * HY_ZSE + t) = w; }
                else { u32x2 w; w.x = cvt_pk_bf16(zn[0], zn[1]); w.y = cvt_pk_bf16(zn[2], zn[3]); *(u32x2*)(zt + 32 * a) = w; }
            }
        }
        __syncthreads();
    }
}

#define KARG_AS __attribute__((address_space(4)))
__device__ __forceinline__ unsigned char* arg_ws() { const char KARG_AS* ka = (const char KARG_AS*)__builtin_amdgcn_kernarg_segment_ptr(); return *(unsigned char* const volatile KARG_AS*)(ka + 8 * 35); }
__device__ __forceinline__ float* arg_out() { const char KARG_AS* ka = (const char KARG_AS*)__builtin_amdgcn_kernarg_segment_ptr(); return *(float* const volatile KARG_AS*)(ka + 8 * 34); }
__device__ __forceinline__ const float* arg_in(int k) {
    const char __attribute__((address_space(4)))* ka = (const char __attribute__((address_space(4)))*)__builtin_amdgcn_kernarg_segment_ptr();
    return *(const float* const volatile __attribute__((address_space(4)))*)(ka + 8 * k);
}
__device__ __forceinline__ int rowmap(int mode, int n) {
    if (mode == 1) { if (n < 1920) return n; const int i = n - 1920; return 1920 + (i < 16 ? 2 * i : 2 * (i - 16) + 1); }
    if (mode == 2) { const int h = n / 96, j = n % 96; if (j < 64) return n; const int i = j - 64; return h * 96 + 64 + (i < 16 ? 2 * i : 2 * (i - 16) + 1); }
    if (mode == 3) { if (n >= 2048) return n; const int j = n & 63; return (n & ~63) + (j < 32 ? 2 * j : 2 * (j - 32) + 1); }
    return n;
}
__device__ __forceinline__ void transpose_item(const float* W, int K, int N, bf16_t* WT, int ldt, int koff, int rowoff, int mode, const float* gain, int gmod, float gs, LAS float* scr, int item, int lane) {
    const int nblk = N / 32, kb = item / nblk, nb = item % nblk, k0 = 64 * kb, n0 = 32 * nb;
    scr[64 * 33 + lane] = gain ? gain[(k0 + lane) % gmod] * gs : gs;
    float t[32];
    const float* src = W + (size_t)(k0 + (lane >> 5)) * N + n0 + (lane & 31);
#pragma unroll
    for (int i = 0; i < 32; ++i) t[i] = src[(size_t)(2 * i) * N];
    asm volatile("s_waitcnt lgkmcnt(0)" ::: "memory");
#pragma unroll
    for (int i = 0; i < 32; ++i) { const int kk = 2 * i + (lane >> 5); scr[kk * 33 + (lane & 31)] = t[i] * scr[64 * 33 + kk]; }
    asm volatile("s_waitcnt lgkmcnt(0)" ::: "memory");
    const int c = lane & 7;
#pragma unroll
    for (int j = 0; j < 4; ++j) { const int n = (lane >> 3) + 8 * j; const LAS float* s = scr + (8 * c) * 33 + n;
        u32x4 o; o.x = cvt_pk_bf16(s[0 * 33], s[1 * 33]); o.y = cvt_pk_bf16(s[2 * 33], s[3 * 33]); o.z = cvt_pk_bf16(s[4 * 33], s[5 * 33]); o.w = cvt_pk_bf16(s[6 * 33], s[7 * 33]);
        *(u32x4*)(WT + (size_t)(rowoff + rowmap(mode, n0 + n)) * ldt + koff + k0 + 8 * c) = o; }
    asm volatile("s_waitcnt lgkmcnt(0)" ::: "memory");
}

__device__ __forceinline__ void phase_prologue(char* lds, int wave0) {
    const int lane = lane_id(), wave = wave0, tid = wave * 64 + lane;
    const int G = gridDim.x, gw = blockIdx.x * NWAVES + wave, NGW = G * NWAVES;
    const long gt = (long)blockIdx.x * NTHREADS + tid, NGT = (long)G * NTHREADS;
    unsigned char* ws = arg_ws();
    LAS float* scr = (LAS float*)((LAS unsigned char*)lds + wave * 16384);
#ifndef PRO_DUP
#define PRO_DUP 0
#endif
    for (int rp_ = 0; rp_ < ((PRO_DUP & 1) ? 2 : 1); ++rp_) {
        constexpr int I0 = 16 * 61, I1 = 4 * 24, I2 = 2 * 32, I3 = 16 * 32, I4 = 16 * 96, I5 = 16 * 32, IXQ = 16 * 32, IXKV = 16 * 64, IXO = 16 * 32, IUP = 16 * 128, IDN = 64 * 32;
        constexpr int NIT = I0 + I1 + I2 + I3 + I4 + I5 + 2 * (IXQ + IXKV + IXO + IUP + IDN);
        for (int it = gw; it < NIT; it += NGW) {
            int r = it;
            if (r < I0) { transpose_item(arg_in(2), 1024, 1952, (bf16_t*)(ws + WS_W_IN), 1024, 0, 0, 1, arg_in(24), 1024, 1.f, scr, r, lane); continue; } r -= I0;
            if (r < I1) { transpose_item(arg_in(13), 256, 768, (bf16_t*)(ws + WS_W_UQ), 256, 0, 0, 2, arg_in(12), 256, 1.f, scr, r, lane); continue; } r -= I1;
            if (r < I2) { transpose_item(arg_in(15), 128, 1024, (bf16_t*)(ws + WS_W_UKV), 256, 128, 0, 0, arg_in(14), 128, 1.f, scr, r, lane); continue; } r -= I2;
            if (r < I3) { transpose_item(arg_in(16), 1024, 1024, (bf16_t*)(ws + WS_W_OUT0), 1024, 0, 0, 0, nullptr, 1, 1.f, scr, r, lane); continue; } r -= I3;
            if (r < I4) { transpose_item(arg_in(17), 1024, 3072, (bf16_t*)(ws + WS_W_QKV), 1024, 0, 0, 3, arg_in(24) + 1024, 1024, 1.f, scr, r, lane); continue; } r -= I4;
            if (r < I5) { transpose_item(arg_in(23), 1024, 1024, (bf16_t*)(ws + WS_W_OUT1), 1024, 0, 0, 0, arg_in(22), 128, 1.0f - LAM_INIT, scr, r, lane); continue; } r -= I5;
            const int l = r / (IXQ + IXKV + IXO + IUP + IDN); r -= l * (IXQ + IXKV + IXO + IUP + IDN);
            if (r < IXQ) { transpose_item(arg_in(27) + (size_t)l * 1024 * 1024, 1024, 1024, (bf16_t*)(ws + WS_W_XQ) + (size_t)l * 1024 * 1024, 1024, 0, 0, 0, arg_in(25) + l * 1024, 1024, 1.f, scr, r, lane); continue; } r -= IXQ;
            if (r < IXKV) { transpose_item(arg_in(28) + (size_t)l * 1024 * 2048, 1024, 2048, (bf16_t*)(ws + WS_W_XKV), 1024, 0, l * 2048, 0, nullptr, 1, 1.f, scr, r, lane); continue; } r -= IXKV;
            if (r < IXO) { transpose_item(arg_in(29) + (size_t)l * 1024 * 1024, 1024, 1024, (bf16_t*)(ws + WS_W_XO) + (size_t)l * 1024 * 1024, 1024, 0, 0, 0, nullptr, 1, 1.f, scr, r, lane); continue; } r -= IXO;
            if (r < IUP) { transpose_item(arg_in(30) + (size_t)l * 1024 * 4096, 1024, 4096, (bf16_t*)(ws + WS_W_UP) + (size_t)l * 4096 * 1024, 1024, 0, 0, 0, arg_in(26) + l * 1024, 1024, 1.f, scr, r, lane); continue; } r -= IUP;
            transpose_item(arg_in(31) + (size_t)l * 4096 * 1024, 4096, 1024, (bf16_t*)(ws + WS_W_DN) + (size_t)l * 1024 * 4096, 4096, 0, 0, 0, nullptr, 1, 1.f, scr, r, lane);
        }
        for (long i = gt; i < 12288 + 16384; i += NGT) {
            if (i < 12288) *(u32x4*)(ws + WS_W_IN + (size_t)1952 * 2048 + i * 16) = (u32x4){0u, 0u, 0u, 0u};
            else { const long k = i - 12288; *(u32x4*)(ws + WS_W_UKV + (size_t)(k >> 4) * 512 + (k & 15) * 16) = (u32x4){0u, 0u, 0u, 0u}; }
        }
    }
    for (int rp_ = 0; rp_ < ((PRO_DUP & 2) ? 2 : 1); ++rp_)
    for (int row0 = gw; row0 < T_TOK + NB * NMEM; row0 += 2 * NGW) {
        f32x4 v[2][4];
#pragma unroll
        for (int u = 0; u < 2; ++u) { const int row = row0 + u * NGW; if (row < T_TOK + NB * NMEM) { const bool isx = row < T_TOK; const int r2 = isx ? row : row - T_TOK;
            const float* src = (isx ? arg_in(0) : arg_in(1)) + (size_t)r2 * DM;
#pragma unroll
            for (int j = 0; j < 4; ++j) v[u][j] = *(const f32x4*)(src + 4 * lane + 256 * j); } }
#pragma unroll
        for (int u = 0; u < 2; ++u) { const int row = row0 + u * NGW; if (row < T_TOK + NB * NMEM) { const bool isx = row < T_TOK; const int r2 = isx ? row : row - T_TOK;
            float s = 0.f;
#pragma unroll
            for (int j = 0; j < 4; ++j) s += (v[u][j].x * v[u][j].x + v[u][j].y * v[u][j].y) + (v[u][j].z * v[u][j].z + v[u][j].w * v[u][j].w);
            s = wave_sum(s);
            if (isx) {
                bf16_t* dst = (bf16_t*)(ws + WS_XB) + (size_t)r2 * DM;
#pragma unroll
                for (int j = 0; j < 4; ++j) { u32x2 w; w.x = cvt_pk_bf16(v[u][j].x, v[u][j].y); w.y = cvt_pk_bf16(v[u][j].z, v[u][j].w); *(u32x2*)(dst + 4 * lane + 256 * j) = w; }
                if (lane < 16) ((float*)(ws + WS_RSS))[(size_t)r2 * 16 + lane] = lane == 0 ? s : 0.f;
            } else {
                const float rn = 1.0f / sqrtf(s * (1.0f / DM) + EPS);
                bf16_t* dst = (bf16_t*)(ws + WS_MEMN) + (size_t)r2 * DM;
#pragma unroll
                for (int j = 0; j < 4; ++j) { const f32x4 gg = *(const f32x4*)(arg_in(32) + 4 * lane + 256 * j);
                    u32x2 w; w.x = cvt_pk_bf16(v[u][j].x * rn * gg.x, v[u][j].y * rn * gg.y); w.y = cvt_pk_bf16(v[u][j].z * rn * gg.z, v[u][j].w * rn * gg.w); *(u32x2*)(dst + 4 * lane + 256 * j) = w; }
            } } }
    }
    {
        const float* w1 = arg_in(5); const float* b1 = arg_in(6); const float* w2 = arg_in(7); const float* b2 = arg_in(8); const float* w3 = arg_in(9); const float* fr = arg_in(10);
        bf16_t* FILT = (bf16_t*)(ws + WS_FILT);
        __syncthreads();
        float* sc = (float*)(lds + wave * 16384);
        float* a2s = (float*)(lds + 8 * 16384);
        for (int rp_ = 0; rp_ < ((PRO_DUP & 8) ? 2 : 1); ++rp_)
        for (int pb = blockIdx.x; pb < SEQ / 8; pb += G) {
            const int l = pb * 8 + wave;
            const float tl = (float)l / 2047.0f, wl = (6.283185307179586f / 2048.0f) * (float)l;
            if (lane < 33) {
                float fv;
                if (lane == 0) fv = tl;
                else { const int kb = (lane - 1) & 15; const float band = 1e-4f + (15.0f - 1e-4f) * ((float)kb / 15.0f); fv = lane <= 16 ? cosf(band * wl) : -sinf(band * wl); }
                sc[lane] = fv;
            }
            float wv[64];
            const float* w1p = w1 + lane; const float* w2p = w2 + lane;
            asm volatile("" : "+v"(w1p), "+v"(w2p));
#pragma unroll
            for (int k = 0; k < 33; ++k) wv[k] = w1p[k * 64];
            asm volatile("s_waitcnt lgkmcnt(0)" ::: "memory");
            float s1 = b1[lane];
#pragma unroll
            for (int k = 0; k < 33; ++k) s1 += sc[k] * wv[k];
            sc[64 + lane] = sinf(fr[lane] * s1);
#pragma unroll
            for (int k = 0; k < 64; ++k) wv[k] = w2p[k * 64];
            asm volatile("s_waitcnt lgkmcnt(0)" ::: "memory");
            float s2 = b2[lane];
#pragma unroll
            for (int k = 0; k < 64; ++k) s2 += sc[64 + k] * wv[k];
            a2s[lane * 8 + wave] = sinf(fr[lane] * s2);
            __syncthreads();
            f32x4 acc[8];
#pragma unroll
            for (int p = 0; p < 8; ++p) acc[p] = (f32x4){0.f, 0.f, 0.f, 0.f};
            const f32x4* rp = (const f32x4*)w3 + tid;
#pragma unroll 1
            for (int kq = 0; kq < 64; kq += 8) {
                asm volatile("" : "+v"(rp));
                f32x4 wq[8];
#pragma unroll
                for (int j = 0; j < 8; ++j) wq[j] = rp[j * 512];
#pragma unroll
                for (int j = 0; j < 8; ++j) {
                    const f32x4 w = wq[j];
                    const f32x4 aL = *(const f32x4*)(a2s + (kq + j) * 8), aH = *(const f32x4*)(a2s + (kq + j) * 8 + 4);
                    acc[0] += aL.x * w; acc[1] += aL.y * w; acc[2] += aL.z * w; acc[3] += aL.w * w;
                    acc[4] += aH.x * w; acc[5] += aH.y * w; acc[6] += aH.z * w; acc[7] += aH.w * w;
                }
                rp += 8 * 512;
            }
            const int col0 = 4 * tid, ord = col0 >> 10, dir = (col0 >> 9) & 1, c0 = col0 & 511;
#pragma unroll
            for (int e = 0; e < 4; ++e) {
                const int c = c0 + e;
                const float delta = -3.0701134573253944f + (-15.350567286626972f + 3.0701134573253944f) * ((float)c / 511.0f);
                float val[8];
#pragma unroll
                for (int p = 0; p < 8; ++p) val[p] = acc[p][e] * expf(-((float)(pb * 8 + p) / 2047.0f) * fabsf(delta));
                bf16_t* R = FILT + (size_t)(ord * 512 + c) * 4096;
                if (dir == 0) {
                    u32x4 wv4; wv4.x = cvt_pk_bf16(val[7], val[6]); wv4.y = cvt_pk_bf16(val[5], val[4]); wv4.z = cvt_pk_bf16(val[3], val[2]); wv4.w = cvt_pk_bf16(val[1], val[0]);
                    *(u32x4*)(R + 2040 - 8 * pb) = wv4;
                } else {
#pragma unroll
                    for (int p = 0; p < 8; ++p) { const int ll = pb * 8 + p; if (ll >= 1) R[2047 + ll] = (bf16_t)f2bf(val[p]); else R[4095] = 0; }
                }
            }
            __syncthreads();
        }
    }
}

#define XB_TMO      128
#define XB_XCNT(j)  (256  + 64 * (j))
#define XB_XSUB(j)  (1280 + 64 * (j))
#define XB_XGEN(j)  (2304 + 64 * (j))
#define XB_TOP      3328
#define XB_TOPGEN   3392
#define XCD_BAR_WORDS 3456
#define XB_SPIN_CAP (1u << 22)
__device__ __forceinline__ unsigned xb_ld(unsigned* p)              { return __hip_atomic_load(p, __ATOMIC_RELAXED, __HIP_MEMORY_SCOPE_AGENT); }
__device__ __forceinline__ unsigned xb_add(unsigned* p, unsigned v) { return __hip_atomic_fetch_add(p, v, __ATOMIC_RELAXED, __HIP_MEMORY_SCOPE_AGENT); }
__device__ __forceinline__ unsigned xb_xcc_id() { return (unsigned)__builtin_amdgcn_s_getreg((3 << 11) | 20) & 0xFu; }
#define XB_SPIN(cond, bar) do { unsigned _sp = 0; while (cond) { __builtin_amdgcn_s_sleep(1); \
    if ((++_sp & 255u) == 0u) { if (xb_ld(&(bar)[XB_TMO])) break; if (_sp > XB_SPIN_CAP) { atomicAdd(&(bar)[XB_TMO], 1u); break; } } } } while (0)
__device__ __forceinline__ void xcd_barrier_complete(unsigned* bar, unsigned x, unsigned& nloc, unsigned& nx) {
    const unsigned G = gridDim.x * gridDim.y * gridDim.z;
    unsigned sum, cnt, mine, sp = 0u;
    for (;;) {
        sum = 0u; cnt = 0u; mine = 0u;
#pragma unroll
        for (unsigned j = 0; j < 16; ++j) { const unsigned c = xb_ld(&bar[XB_XCNT(j)]); sum += c; cnt += (c > 0u) ? 1u : 0u; mine = (j == x) ? c : mine; }
        if (sum == G) break;
        __builtin_amdgcn_s_sleep(1);
        if ((++sp & 255u) == 0u) { if (xb_ld(&bar[XB_TMO])) break; if (sp > XB_SPIN_CAP) { atomicAdd(&bar[XB_TMO], 1u); break; } }
    }
    nloc = mine > 0u ? mine : 1u; nx = cnt > 0u ? cnt : 1u;
}
__device__ __forceinline__ void xcd_barrier(unsigned* bar, volatile LAS unsigned* st, bool leader) {
    asm volatile("s_waitcnt vmcnt(0)" ::: "memory");
    __syncthreads();
    if (leader) {
        __builtin_amdgcn_s_waitcnt(0);
        const unsigned x = xb_xcc_id();
        unsigned nloc = st[0], nx = st[1];
        if (nloc == 0u) { xcd_barrier_complete(bar, x, nloc, nx); st[0] = nloc; st[1] = nx; }
        const unsigned old = xb_add(&bar[XB_XSUB(x)], 1u);
        const unsigned gen = old / nloc;
        if (old + 1u == (gen + 1u) * nloc) {
            __builtin_amdgcn_fence(__ATOMIC_RELEASE, "agent");
            asm volatile("s_waitcnt vmcnt(0)" ::: "memory");
            const unsigned og = xb_add(&bar[XB_TOP], 1u);
            const unsigned tg = og / nx;
            if (og + 1u == (tg + 1u) * nx) xb_add(&bar[XB_TOPGEN], 1u);
            else XB_SPIN(xb_ld(&bar[XB_TOPGEN]) == tg, bar);
            __builtin_amdgcn_fence(__ATOMIC_ACQUIRE, "agent");
            xb_add(&bar[XB_XGEN(x)], 1u);
            asm volatile("s_waitcnt vmcnt(0)" ::: "memory");
        } else {
            XB_SPIN(xb_ld(&bar[XB_XGEN(x)]) == gen, bar);
            __builtin_amdgcn_fence(__ATOMIC_ACQUIRE, "agent");
            asm volatile("s_waitcnt vmcnt(0)" ::: "memory");
        }
    }
    __syncthreads();
}
#ifndef PH3_SUB
#define PH3_SUB 3
#endif
__global__ void __launch_bounds__(NTHREADS, 2) fwd_megakernel(Args a) {
    extern __shared__ __attribute__((aligned(16))) unsigned char lds_[];
    cg::grid_group grid = cg::this_grid();
    LAS unsigned char* ldsl = (LAS unsigned char*)lds_;
    char* lds = (char*)lds_;
    const int wave0 = __builtin_amdgcn_readfirstlane((int)threadIdx.x >> 6);
    const int G = gridDim.x, bx = blockIdx.x;
    const int vcu = (G % 8 == 0) ? (bx % 8) * (G / 8) + bx / 8 : bx;
#ifndef PH_MASK
#define PH_MASK 0x1fffff
#endif
#define IN(k) ((PH_MASK >> (k)) & 1)
#ifndef DUP_PHASE
#define DUP_PHASE -1
#endif
#ifndef DUP3_SUB
#define DUP3_SUB 3
#endif
#define REPS(k) ((k) == DUP_PHASE ? 2 : 1)
    volatile LAS unsigned* bst = (volatile LAS unsigned*)(ldsl + LDS_BYTES - 64);
    const bool leader = (wave0 == 0) && (lane_id() == 0);
    if (leader) { bst[0] = 0u; bst[1] = 0u; (void)xb_add((unsigned*)arg_ws() + XB_XCNT(xb_xcc_id()), 1u); }
    __syncthreads();
    if (a.ph_lo == 0x7fffffff) grid.sync();
#define LOCAL_SEAM(k) do { if (IN(k) && IN((k) + 1)) { asm volatile("s_waitcnt vmcnt(0)" ::: "memory"); __syncthreads(); \
        if (wave0 == 0) { __builtin_amdgcn_fence(__ATOMIC_ACQUIRE, "agent"); asm volatile("s_waitcnt vmcnt(0)" ::: "memory"); } __syncthreads(); } } while (0)
#define SYNC(k) do { if (IN(k) && IN((k) + 1)) xcd_barrier((unsigned*)arg_ws(), bst, (wave0 == 0) && (lane_id() == 0)); } while (0)
#define WSP(name, T, off) T* name = (T*)(wsp + (off))
    if (IN(0)) for (int rep_ = 0; rep_ < REPS(0); ++rep_) phase_prologue(lds, wave0);
    SYNC(0);
    if (IN(1)) for (int rep_ = 0; rep_ < REPS(1); ++rep_) {
        unsigned char* wsp = arg_ws();
        WSP(RSS, float, WS_RSS); WSP(LSS, float, WS_LSS); WSP(XB, bf16_t, WS_XB); WSP(HYT, bf16_t, WS_HYT); WSP(LAT, bf16_t, WS_LAT); WSP(KM, bf16_t, WS_KM); WSP(MEMK, bf16_t, WS_MEMK); WSP(VT, bf16_t, WS_VT);
        run_gemm(ldsl, wave0, XB, DM, (const bf16_t*)(wsp + WS_W_IN), DM, T_TOK, 2048, DM, EpiIn{RSS, HYT, LAT, LSS, KM});
        run_gemm(ldsl, wave0, (const bf16_t*)(wsp + WS_MEMN), DM, (const bf16_t*)(wsp + WS_W_XKV), DM, NB * NMEM, 4096, DM, EpiMemKV{MEMK, VT});
    }
    SYNC(1);
    if (IN(2)) for (int rep_ = 0; rep_ < REPS(2); ++rep_) {
        unsigned char* wsp = arg_ws();
        WSP(LSS, float, WS_LSS); WSP(LAT, bf16_t, WS_LAT); WSP(QM, bf16_t, WS_QM); WSP(KM, bf16_t, WS_KM); WSP(VM, bf16_t, WS_VM);
        run_gemm(ldsl, wave0, LAT, 384, (const bf16_t*)(wsp + WS_W_UQ), 256, T_TOK, 768, 256, EpiUq{LSS, QM});
        run_gemm(ldsl, wave0, LAT + 128, 384, (const bf16_t*)(wsp + WS_W_UKV), 256, T_TOK, 1024, 256, EpiUkv{LSS, KM, VM});
    }
    SYNC(2);
    if (IN(3)) for (int rep_ = 0; rep_ < REPS(3); ++rep_) {
        unsigned char* wsp = arg_ws();
        WSP(ACT1, bf16_t, WS_ACT1); WSP(HYT, bf16_t, WS_HYT); WSP(QM, bf16_t, WS_QM); WSP(KM, bf16_t, WS_KM); WSP(VM, bf16_t, WS_VM);
        unsigned* hcnt = (unsigned*)wsp + 3584 + 64 * rep_;
        if ((PH3_SUB & 1) && (rep_ == 0 || (DUP3_SUB & 1))) for (int c = vcu; c < 512; c += G) hyena_unit(lds, wave0, c, HYT, (const bf16_t*)(wsp + WS_FILT), arg_in(3), arg_in(4), arg_in(11), HYT);
        asm volatile("s_waitcnt vmcnt(0)" ::: "memory"); __syncthreads();
        if (wave0 == 0 && lane_id() == 0) { __builtin_amdgcn_fence(__ATOMIC_RELEASE, "agent"); asm volatile("s_waitcnt vmcnt(0)" ::: "memory"); (void)xb_add(hcnt, 1u); }
        const int upc = (1024 + G - 1) / G;
        if ((PH3_SUB & 2) && (rep_ == 0 || (DUP3_SUB & 2))) for (int r_ = 0; r_ < 4 && G == 256; ++r_) {
            const int xc = vcu >> 5, cc = vcu & 31, bh = xc * 16 + r_ * 4 + (cc >> 3), qb = cc & 7, b = bh >> 3, h = bh & 7;
            const size_t row0 = (size_t)b * SEQ + qb * 256;
            AttnIO io{QM + row0 * 768 + h * 96, 768, KM + (size_t)b * SEQ * 768 + h * 96, 768, VM + (size_t)b * SEQ * 512 + h * 64, 512, ACT1 + row0 * DM + 512 + h * 64, DM, 0.f};
            attn_unit_d<0>(lds, wave0, io);
        }
        if (wave0 == 0 && lane_id() == 0) { unsigned sp = 0; while (xb_ld(hcnt) < (unsigned)G) { __builtin_amdgcn_s_sleep(2); if (++sp > (1u << 24)) break; }
            __builtin_amdgcn_fence(__ATOMIC_ACQUIRE, "agent"); asm volatile("s_waitcnt vmcnt(0)" ::: "memory"); }
        __syncthreads();
        {
            const int lane = lane_id();
            bf16_t* tl = (bf16_t*)(lds + wave0 * 16384);
            for (int it = bx * NWAVES + wave0; it < 512 * 8; it += G * NWAVES) {
                const int t0 = (it >> 3) * 64, c0 = (it & 7) * 64;
#pragma unroll
                for (int k = 0; k < 8; ++k) { const int cc = 8 * k + (lane >> 3), ch = lane & 7;
                    *(u32x4*)(tl + cc * 72 + ch * 8) = *(const u32x4*)(HYT + (size_t)(c0 + cc) * T_TOK + t0 + ch * 8); }
                asm volatile("s_waitcnt lgkmcnt(0)" ::: "memory");
#pragma unroll
                for (int k = 0; k < 8; ++k) { const int tt = 8 * k + (lane >> 3), ch = lane & 7;
                    unsigned short e[8];
#pragma unroll
                    for (int j = 0; j < 8; ++j) e[j] = tl[(ch * 8 + j) * 72 + tt];
                    u32x4 w; w.x = e[0] | ((unsigned)e[1] << 16); w.y = e[2] | ((unsigned)e[3] << 16); w.z = e[4] | ((unsigned)e[5] << 16); w.w = e[6] | ((unsigned)e[7] << 16);
                    *(u32x4*)(ACT1 + (size_t)(t0 + tt) * DM + c0 + ch * 8) = w; }
                asm volatile("s_waitcnt lgkmcnt(0)" ::: "memory");
            }
        }
    }
    SYNC(3);
    if (IN(4)) for (int rep_ = 0; rep_ < REPS(4); ++rep_) {
        unsigned char* wsp = arg_ws();
        WSP(RSS, float, WS_RSS); WSP(XB, bf16_t, WS_XB); WSP(ACT1, bf16_t, WS_ACT1);
        run_gemm(ldsl, wave0, ACT1, DM, (const bf16_t*)(wsp + WS_W_OUT0), DM, T_TOK, DM, DM, EpiRes{XB, (REPS(4) == 2 && rep_ == 0) ? (bf16_t*)(wsp + WS_BIG + 96 * MiB) : XB, (REPS(4) == 2 && rep_ == 0) ? (float*)(wsp + 5 * MiB) : RSS});
    }
    SYNC(4);
    for (int l = 0; l < 2; ++l) {
        if (l == 1) {
            if (IN(11)) for (int rep_ = 0; rep_ < REPS(11); ++rep_) {
                unsigned char* wsp = arg_ws();
                WSP(RSS, float, WS_RSS); WSP(XB, bf16_t, WS_XB); WSP(QKV, bf16_t, WS_QKV);
                run_gemm(ldsl, wave0, XB, DM, (const bf16_t*)(wsp + WS_W_QKV), DM, T_TOK, 3072, DM, EpiQkv{RSS, QKV});
            }
            SYNC(11);
            if (IN(12)) for (int rep_ = 0; rep_ < REPS(12); ++rep_) {
                unsigned char* wsp = arg_ws();
                WSP(ACT1, bf16_t, WS_ACT1); WSP(QKV, bf16_t, WS_QKV);
                float d1 = 0.f, d2 = 0.f;
                { const float* q1 = arg_in(18); const float* k1 = arg_in(19); const float* q2 = arg_in(20); const float* k2 = arg_in(21);
                  for (int k = 0; k < 64; ++k) { d1 += q1[k] * k1[k]; d2 += q2[k] * k2[k]; } }
                const float lam = expf(d1) - expf(d2) + LAM_INIT;
                const int upc = (2048 + G - 1) / G;
                for (int r_ = 0; r_ < 8 && G == 256; ++r_) {
                    const int xc = vcu >> 5, cc = vcu & 31, bh = xc * 16 + r_ * 2 + (cc >> 4), rt = cc & 15, b = bh >> 3, h = bh & 7;
                    const size_t row0 = (size_t)b * SEQ + rt * 128;
                    AttnIO io{QKV + row0 * 3072 + h * 128, 3072, QKV + (size_t)b * SEQ * 3072 + 1024 + h * 128, 3072, QKV + (size_t)b * SEQ * 3072 + 2048 + h * 128, 3072, ACT1 + row0 * DM + h * 128, DM, lam};
                    attn_unit_d<1>(lds, wave0, io);
                }
            }
            SYNC(12);
            if (IN(13)) for (int rep_ = 0; rep_ < REPS(13); ++rep_) {
                unsigned char* wsp = arg_ws();
                WSP(RSS, float, WS_RSS); WSP(XB, bf16_t, WS_XB); WSP(ACT1, bf16_t, WS_ACT1);
                run_gemm(ldsl, wave0, ACT1, DM, (const bf16_t*)(wsp + WS_W_OUT1), DM, T_TOK, DM, DM, EpiRes{XB, (REPS(13) == 2 && rep_ == 0) ? (bf16_t*)(wsp + WS_BIG + 192 * MiB) : XB, (REPS(13) == 2 && rep_ == 0) ? (float*)(wsp + 5 * MiB) : RSS});
            }
            SYNC(13);
        }
        const int p_xq = l == 0 ? 5 : 14;
        if (IN(p_xq)) for (int rep_ = 0; rep_ < REPS(p_xq); ++rep_) {
            unsigned char* wsp = arg_ws();
            WSP(RSS, float, WS_RSS); WSP(XB, bf16_t, WS_XB); WSP(ACT1, bf16_t, WS_ACT1);
            run_gemm(ldsl, wave0, XB, DM, (const bf16_t*)(wsp + WS_W_XQ) + (size_t)l * DM * DM, DM, T_TOK, DM, DM, EpiNormBf16{RSS, ACT1, DM, 0.0625f * LOG2E});
        }
        LOCAL_SEAM(p_xq);
        if (IN(p_xq + 1)) for (int rep_ = 0; rep_ < REPS(p_xq + 1); ++rep_) {
            unsigned char* wsp = arg_ws();
            WSP(ACT1, bf16_t, WS_ACT1); WSP(MEMK, bf16_t, WS_MEMK); WSP(PBUF, bf16_t, WS_PBUF);
            run_gemm_ad(ldsl, wave0, DM, 2048, T_TOK, DM, 256, pg8::EpiSoftmax{PBUF, DM}, AddrXS{(const char*)ACT1, (const char*)(MEMK + l * 1024)});
        }
        LOCAL_SEAM(p_xq + 1);
        if (IN(p_xq + 2)) for (int rep_ = 0; rep_ < REPS(p_xq + 2); ++rep_) {
            unsigned char* wsp = arg_ws();
            WSP(ACT1, bf16_t, WS_ACT1); WSP(VT, bf16_t, WS_VT); WSP(PBUF, bf16_t, WS_PBUF);
            run_gemm_ad(ldsl, wave0, DM, 256, T_TOK, DM, 256, pg8::Epi8<EpiPlain>{EpiPlain{ACT1, DM}}, AddrXV{(const char*)PBUF, (const char*)(VT + (size_t)l * NB * 1024 * 256)});
        }
        SYNC(p_xq + 2);
        if (IN(p_xq + 3)) for (int rep_ = 0; rep_ < REPS(p_xq + 3); ++rep_) {
            unsigned char* wsp = arg_ws();
            WSP(RSS, float, WS_RSS); WSP(XB, bf16_t, WS_XB); WSP(ACT1, bf16_t, WS_ACT1);
            run_gemm(ldsl, wave0, ACT1, DM, (const bf16_t*)(wsp + WS_W_XO) + (size_t)l * DM * DM, DM, T_TOK, DM, DM, EpiRes{XB, (REPS(p_xq + 3) == 2 && rep_ == 0) ? (bf16_t*)(wsp + WS_BIG + 64 * MiB) : XB, (REPS(p_xq + 3) == 2 && rep_ == 0) ? (float*)(wsp + 5 * MiB) : RSS});
        }
        SYNC(p_xq + 3);
        if (IN(p_xq + 4)) for (int rep_ = 0; rep_ < REPS(p_xq + 4); ++rep_) {
            unsigned char* wsp = arg_ws();
            WSP(RSS, float, WS_RSS); WSP(XB, bf16_t, WS_XB); WSP(HMID, bf16_t, WS_HMID);
            run_gemm(ldsl, wave0, XB, DM, (const bf16_t*)(wsp + WS_W_UP) + (size_t)l * DFF * DM, DM, T_TOK, DFF, DM, EpiUp{RSS, HMID});
        }
        SYNC(p_xq + 4);
        if (IN(p_xq + 5)) for (int rep_ = 0; rep_ < REPS(p_xq + 5); ++rep_) {
            unsigned char* wsp = arg_ws();
            WSP(RSS, float, WS_RSS); WSP(XB, bf16_t, WS_XB); WSP(HMID, bf16_t, WS_HMID);
            run_gemm(ldsl, wave0, HMID, DFF, (const bf16_t*)(wsp + WS_W_DN) + (size_t)l * DM * DFF, DFF, T_TOK, DM, DFF, EpiRes{XB, (REPS(p_xq + 5) == 2 && rep_ == 0) ? (bf16_t*)(wsp + WS_ACT1) : XB, (REPS(p_xq + 5) == 2 && rep_ == 0) ? (float*)(wsp + 5 * MiB) : RSS});
        }
        SYNC(p_xq + 5);
    }
    if (IN(20)) for (int rep_ = 0; rep_ < REPS(20); ++rep_) {
        const int lane = lane_id(), wave = wave0;
        const float* gfin = arg_in(33); float* outp = arg_out(); const bf16_t* XB = (const bf16_t*)(arg_ws() + WS_XB);
        for (int row = bx * NWAVES + wave; row < T_TOK; row += G * NWAVES) {
            const u32x4 a0 = *(const u32x4*)(XB + (size_t)row * DM + 8 * lane), a1 = *(const u32x4*)(XB + (size_t)row * DM + 512 + 8 * lane);
            float v[16];
            v[0] = __builtin_bit_cast(float, a0.x << 16); v[1] = __builtin_bit_cast(float, a0.x & 0xffff0000u); v[2] = __builtin_bit_cast(float, a0.y << 16); v[3] = __builtin_bit_cast(float, a0.y & 0xffff0000u);
            v[4] = __builtin_bit_cast(float, a0.z << 16); v[5] = __builtin_bit_cast(float, a0.z & 0xffff0000u); v[6] = __builtin_bit_cast(float, a0.w << 16); v[7] = __builtin_bit_cast(float, a0.w & 0xffff0000u);
            v[8] = __builtin_bit_cast(float, a1.x << 16); v[9] = __builtin_bit_cast(float, a1.x & 0xffff0000u); v[10] = __builtin_bit_cast(float, a1.y << 16); v[11] = __builtin_bit_cast(float, a1.y & 0xffff0000u);
            v[12] = __builtin_bit_cast(float, a1.z << 16); v[13] = __builtin_bit_cast(float, a1.z & 0xffff0000u); v[14] = __builtin_bit_cast(float, a1.w << 16); v[15] = __builtin_bit_cast(float, a1.w & 0xffff0000u);
            float s = 0.f;
#pragma unroll
            for (int j = 0; j < 16; ++j) s += v[j] * v[j];
            s = wave_sum(s);
            const float rn = 1.0f / sqrtf(s * (1.0f / DM) + EPS);
            float* p = outp + (size_t)row * DM;
#pragma unroll
            for (int h = 0; h < 2; ++h)
#pragma unroll
                for (int q = 0; q < 2; ++q) { const int c = 512 * h + 8 * lane + 4 * q; const f32x4 gg = *(const f32x4*)(gfin + c);
                    *(f32x4*)(p + c) = (f32x4){v[8 * h + 4 * q] * rn * gg.x, v[8 * h + 4 * q + 1] * rn * gg.y, v[8 * h + 4 * q + 2] * rn * gg.z, v[8 * h + 4 * q + 3] * rn * gg.w}; }
        }
    }
#undef IN
#undef SYNC
}

extern "C" void kernel_launch(void* const* d_in, const int* in_sizes, int n_in, void* d_out, int out_size,
                              void* d_ws, size_t ws_size, hipStream_t stream) {
    static int grid = 0;
    if (grid == 0) {
        if (n_in != 34 || out_size != T_TOK * DM || ws_size < WS_END) { fprintf(stderr, "kernel_launch: unexpected shapes n_in %d out %d ws %zu (need %zu)\n", n_in, out_size, ws_size, (size_t)WS_END); grid = -1; return; }
        int dev = 0, cus = 0, per_cu = 0;
        (void)hipGetDevice(&dev);
        (void)hipDeviceGetAttribute(&cus, hipDeviceAttributeMultiprocessorCount, dev);
        (void)hipFuncSetAttribute((const void*)fwd_megakernel, hipFuncAttributeMaxDynamicSharedMemorySize, LDS_BYTES);
        (void)hipOccupancyMaxActiveBlocksPerMultiprocessor(&per_cu, (const void*)fwd_megakernel, NTHREADS, LDS_BYTES);
        if (per_cu < 1) { fprintf(stderr, "kernel_launch: occupancy query reports %d blocks per CU\n", per_cu); }
        grid = cus;
        if (cus != 256) fprintf(stderr, "kernel_launch: built for a 256-CU device (attention unit maps assume 256 workgroups); this device reports %d CUs\n", cus);
    }
    if (grid < 0) return;
    (void)hipMemsetAsync(d_ws, 0, 16384, stream);
    Args a{};
    for (int i = 0; i < 34; ++i) a.in[i] = (const float*)d_in[i];
    a.out = (float*)d_out; a.ws = (unsigned char*)d_ws; a.ph_lo = 0; a.ph_hi = 21;
    void* args[] = {&a};
    hipError_t e = hipLaunchCooperativeKernel((const void*)fwd_megakernel, dim3(grid), dim3(NTHREADS), args, LDS_BYTES, stream);
    if (e != hipSuccess) fprintf(stderr, "cooperative launch failed: %s (grid %d)\n", hipGetErrorString(e), grid);
}
```

```cpp
#include <hip/hip_runtime.h>
#include <hip/hip_cooperative_groups.h>
#include <cstdio>
#include <cstdint>
namespace cg = cooperative_groups;

#define LAS __attribute__((address_space(3)))
typedef unsigned short bf16_t;
typedef short bf16x8 __attribute__((ext_vector_type(8)));
typedef short s16x4 __attribute__((ext_vector_type(4)));
typedef float f32x4 __attribute__((ext_vector_type(4)));
typedef float f32x16 __attribute__((ext_vector_type(16)));
typedef unsigned u32x4 __attribute__((ext_vector_type(4)));
typedef unsigned u32x2 __attribute__((ext_vector_type(2)));

constexpr int T_TOK = 32768, SEQ = 2048, NB = 16, DM = 1024, NMEM = 256, DFF = 4096;
constexpr float EPS = 1e-6f, SUBLN_EPS = 1e-5f;
constexpr float LOG2E = 1.4426950408889634f;
constexpr float LAM_INIT = 0.35550906758f;
constexpr int NTHREADS = 512, NWAVES = 8;
constexpr int LDS_BYTES = 147456;

constexpr size_t MiB = 1u << 20;
constexpr size_t WS_ROPE_R = 1 * MiB;
constexpr size_t WS_ROPE_D = 1 * MiB + 512 * 1024;
constexpr size_t WS_RSS = 2 * MiB;
constexpr size_t WS_LSS = 4 * MiB;
constexpr size_t WS_FILT = 8 * MiB;
constexpr size_t WS_MEMK = 16 * MiB;
constexpr size_t WS_VT = 32 * MiB;
constexpr size_t WS_PBUF = 248 * MiB;
constexpr size_t WS_MEMN = 48 * MiB;
constexpr size_t WS_W_IN = 56 * MiB;
constexpr size_t WS_W_UQ = 60 * MiB;
constexpr size_t WS_W_UKV = 60 * MiB + 512 * 1024;
constexpr size_t WS_W_OUT0 = 61 * MiB;
constexpr size_t WS_W_QKV = 63 * MiB;
constexpr size_t WS_W_OUT1 = 69 * MiB;
constexpr size_t WS_W_XKV = 71 * MiB;
constexpr size_t WS_W_XQ = 79 * MiB;
constexpr size_t WS_W_XO = 83 * MiB;
constexpr size_t WS_W_UP = 87 * MiB;
constexpr size_t WS_W_DN = 103 * MiB;
constexpr size_t WS_XB = 120 * MiB;
constexpr size_t WS_ACT1 = 184 * MiB;
constexpr size_t WS_BIG = 248 * MiB;
constexpr size_t WS_HYT = WS_BIG;
constexpr size_t WS_LAT = WS_BIG + 96 * MiB;
constexpr size_t WS_QM = WS_BIG + 120 * MiB;
constexpr size_t WS_KM = WS_BIG + 168 * MiB;
constexpr size_t WS_VM = WS_BIG + 216 * MiB;
constexpr size_t WS_QKV = WS_BIG;
constexpr size_t WS_HMID = WS_BIG;
constexpr size_t WS_END = 504 * MiB;

struct Args { const float* in[34]; float* out; unsigned char* ws; int ph_lo, ph_hi; };

__device__ __forceinline__ int lane_id() { int l; asm volatile("v_mbcnt_lo_u32_b32 %0, -1, 0\n\tv_mbcnt_hi_u32_b32 %0, -1, %0" : "=v"(l)); return l; }
__device__ __forceinline__ unsigned cvt_pk_bf16(float lo, float hi) { unsigned r; asm volatile("v_cvt_pk_bf16_f32 %0, %1, %2" : "=v"(r) : "v"(lo), "v"(hi)); return r; }
__device__ __forceinline__ unsigned f2bf(float f) { unsigned u = __builtin_bit_cast(unsigned, f); return (u + 0x7fffu + ((u >> 16) & 1u)) >> 16; }
__device__ __forceinline__ float bf2f(unsigned short b) { return __builtin_bit_cast(float, (unsigned)b << 16); }
__device__ __forceinline__ float shx(float v, int mask) { const int l = lane_id(); return __builtin_bit_cast(float, __builtin_amdgcn_ds_bpermute((l ^ mask) << 2, __builtin_bit_cast(int, v))); }
__device__ __forceinline__ float wave_sum(float v) {
#pragma unroll
    for (int o = 1; o < 64; o <<= 1) v += shx(v, o);
    return v;
}
__device__ __forceinline__ u32x4 pack8(const float (&v)[8]) { u32x4 w; w.x = cvt_pk_bf16(v[0], v[1]); w.y = cvt_pk_bf16(v[2], v[3]); w.z = cvt_pk_bf16(v[4], v[5]); w.w = cvt_pk_bf16(v[6], v[7]); return w; }
__device__ __forceinline__ void st16_rows(bf16_t* O, size_t ld, int row, int col0, u32x4 w) {
    const int d = (int)__builtin_amdgcn_mbcnt_hi(~0u, __builtin_amdgcn_mbcnt_lo(~0u, 0u));
    const int src4 = ((((d & 3) << 4) | (d >> 2)) << 2);
    w.x = (unsigned)__builtin_amdgcn_ds_bpermute(src4, (int)w.x); w.y = (unsigned)__builtin_amdgcn_ds_bpermute(src4, (int)w.y);
    w.z = (unsigned)__builtin_amdgcn_ds_bpermute(src4, (int)w.z); w.w = (unsigned)__builtin_amdgcn_ds_bpermute(src4, (int)w.w);
    const int nrow = row - (d & 15) + (d >> 2), ncol = col0 - 8 * (d >> 4) + 8 * (d & 3);
    *(u32x4*)(O + (size_t)nrow * ld + ncol) = w;
}
__device__ __forceinline__ void st16_rows_nt(bf16_t* O, size_t ld, int row, int col0, u32x4 w) {
    const int d = (int)__builtin_amdgcn_mbcnt_hi(~0u, __builtin_amdgcn_mbcnt_lo(~0u, 0u));
    const int src4 = ((((d & 3) << 4) | (d >> 2)) << 2);
    w.x = (unsigned)__builtin_amdgcn_ds_bpermute(src4, (int)w.x); w.y = (unsigned)__builtin_amdgcn_ds_bpermute(src4, (int)w.y);
    w.z = (unsigned)__builtin_amdgcn_ds_bpermute(src4, (int)w.z); w.w = (unsigned)__builtin_amdgcn_ds_bpermute(src4, (int)w.w);
    const int nrow = row - (d & 15) + (d >> 2), ncol = col0 - 8 * (d >> 4) + 8 * (d & 3);
    __builtin_nontemporal_store(w, (u32x4*)(O + (size_t)nrow * ld + ncol));
}

namespace pg8 {
constexpr int BM = 256, BK = 64, HALF = 128, HTB = HALF * BK * 2, STAGE_BYTES = 8 * HTB, NXCD = 8, WGM = 8;
__host__ __device__ __forceinline__ int lds_byte(int r, int c) { const int st = (r >> 4) * 2 + (c >> 5), rr = r & 15, cc = c & 31, ob = rr * 64 + cc * 2; return st * 1024 + (ob ^ (((ob >> 9) & 1) << 5)); }
__host__ __device__ __forceinline__ void stage_rc(int b, int& R, int& C) { const int st = b / 1024, sb = b % 1024, swz = sb ^ (((sb >> 9) & 1) << 5); R = (st >> 1) * 16 + swz / 64; C = (st & 1) * 32 + (swz % 64) / 2; }
__host__ __device__ __forceinline__ int perm32(int rho) { const int n = rho >> 4, i = rho & 15; return 8 * (i >> 2) + 4 * n + (i & 3); }
struct Unit { int pm, pn; };
struct Gemm { const bf16_t* A; const bf16_t* Bt; int M, N, K, lda, ldb; };
struct AddrStd {
    const char* A; const char* B; size_t tA, tB;
    __device__ __forceinline__ const char* a(const Unit& u) const { return A + (size_t)u.pm * tA; }
    __device__ __forceinline__ const char* b(const Unit& u) const { return B + (size_t)u.pn * tB; }
};
struct StaticOrder {
    int nM, nN, nwg, G, c;
    __device__ void init(int M, int N, int G_, int c_) { nM = M / BM; nN = N / BM; nwg = nM * nN; G = G_; c = c_; }
    __device__ bool next(int i, Unit& u) const {
        const long L = (long)i * G + c; if (L >= nwg) return false;
        int wgid = (int)L; { const int q = nwg / NXCD, r = nwg % NXCD, xcd = wgid % NXCD, off = wgid / NXCD; wgid = (xcd < r ? xcd * (q + 1) : r * (q + 1) + (xcd - r) * q) + off; }
        const int nig = WGM * nN, gid = wgid / nig, fm = gid * WGM, gsz = (nM - fm) < WGM ? (nM - fm) : WGM;
        u.pm = fm + ((wgid % nig) % gsz); u.pn = (wgid % nig) / gsz; return true;
    }
};

template <class Epi, class Addr>
__device__ __forceinline__ void gemm_phase(LAS unsigned char* lds, int wave0, const Gemm g, const StaticOrder& S, const Epi& E, const Addr& AD) {
    int tid_ = wave0 * 64 + lane_id(); asm volatile("" : "+v"(tid_));
    const int tid = tid_, wid = __builtin_amdgcn_readfirstlane(tid >> 6), lane = tid & 63, wr = wid >> 2, wc = wid & 3, fr = lane & 15, fq = lane >> 4;
    const int K = g.K, nt = K / BK;
    unsigned voffA[2], voffB[2];
#pragma unroll
    for (int i = 0; i < 2; ++i) { int R, C; stage_rc(tid * 16 + i * 8192, R, C); const int Rb = ((R & ~31) + perm32(R & 31));
        voffA[i] = (unsigned)(R * g.lda + C) * 2u; voffB[i] = (unsigned)(Rb * g.ldb + C) * 2u; }
    const size_t kstep = (size_t)(BK * 2);
    const size_t hstepA = (size_t)HALF * g.lda * 2, hstepB = (size_t)HALF * g.ldb * 2;
    const unsigned ldsw = (unsigned)wid * 1024u;
    const int aoff = lds_byte(wr * 64 + fr, fq * 8), boff = lds_byte(wc * 32 + fr, fq * 8);
#define PG8_SA(b, h) (((b) * 2 + (h)) * HTB)
#define PG8_SB(b, h) ((4 + (b) * 2 + (h)) * HTB)
#define PG8_STAGE(bufoff, gbase, voff) do { _Pragma("unroll") for (int _i = 0; _i < 2; ++_i) \
        __builtin_amdgcn_global_load_lds((const unsigned*)((const char*)(gbase) + (voff)[_i]), (LAS unsigned*)(lds + (bufoff) + ldsw + _i * 8192), 16, 0, 0); } while (0)
#define PG8_LDA(dst, b, h) do { _Pragma("unroll") for (int m = 0; m < 4; ++m) _Pragma("unroll") for (int k = 0; k < 2; ++k) dst[m][k] = *(const LAS bf16x8*)(lds + PG8_SA(b, h) + aoff + m * 2048 + k * 1024); } while (0)
#define PG8_LDB(dst, b, h) do { _Pragma("unroll") for (int n = 0; n < 2; ++n) _Pragma("unroll") for (int k = 0; k < 2; ++k) dst[n][k] = *(const LAS bf16x8*)(lds + PG8_SB(b, h) + boff + n * 2048 + k * 1024); } while (0)
#define PG8_MMA(ai, bj, At, Bt) do { __builtin_amdgcn_s_setprio(1); _Pragma("unroll") for (int m = 0; m < 4; ++m) _Pragma("unroll") for (int n = 0; n < 2; ++n) _Pragma("unroll") for (int k = 0; k < 2; ++k) \
        acc[ai][bj][m][n] = __builtin_amdgcn_mfma_f32_16x16x32_bf16(Bt[n][k], At[m][k], acc[ai][bj][m][n], 0, 0, 0); __builtin_amdgcn_s_setprio(0); } while (0)
#define PG8_MMA0(ai, bj, At, Bt) do { __builtin_amdgcn_s_setprio(1); _Pragma("unroll") for (int m = 0; m < 4; ++m) _Pragma("unroll") for (int n = 0; n < 2; ++n) { \
        acc[ai][bj][m][n] = __builtin_amdgcn_mfma_f32_16x16x32_bf16(Bt[n][0], At[m][0], (f32x4){0.f, 0.f, 0.f, 0.f}, 0, 0, 0); \
        acc[ai][bj][m][n] = __builtin_amdgcn_mfma_f32_16x16x32_bf16(Bt[n][1], At[m][1], acc[ai][bj][m][n], 0, 0, 0); } __builtin_amdgcn_s_setprio(0); } while (0)
#define PG8_WAIT_V(n) asm volatile("s_waitcnt vmcnt(" #n ")" ::: "memory")
#define PG8_WAIT_L(n) asm volatile("s_waitcnt lgkmcnt(" #n ")" ::: "memory")
#define PG8_BAR __builtin_amdgcn_s_barrier()
#define PG8_SCHED __builtin_amdgcn_sched_barrier(0)
    Unit cur, nxt; int ui = 0;
    if (!S.next(0, cur)) return;
    E.prep(lds, S, tid);
    f32x4 acc[2][2][4][2];
    bf16x8 At[4][2], B0[2][2], B1[2][2];
    const char* cA = AD.a(cur); const char* cB = AD.b(cur);
    {
        PG8_STAGE(PG8_SB(0, 0), cB, voffB); PG8_STAGE(PG8_SB(0, 1), cB + hstepB, voffB); PG8_STAGE(PG8_SA(0, 0), cA, voffA); PG8_STAGE(PG8_SA(0, 1), cA + hstepA, voffA);
        if (wr == 1) PG8_BAR;
        PG8_WAIT_V(2); PG8_BAR;
        PG8_STAGE(PG8_SB(1, 0), cB + kstep, voffB); PG8_STAGE(PG8_SA(1, 0), cA + kstep, voffA); PG8_STAGE(PG8_SB(1, 1), cB + hstepB + kstep, voffB);
        PG8_WAIT_V(6); PG8_BAR;
    }
    for (;;) {
        const bool has_next = S.next(ui + 1, nxt);
        const char* nA = has_next ? AD.a(nxt) : cA; const char* nB = has_next ? AD.b(nxt) : cB;
#define PG8_BODY(t, MMAF) do { \
            const bool last = ((t) == nt - 2); \
            const char* a1 = cA + (size_t)((t) + 1) * kstep; \
            const char* a2 = last ? nA : cA + (size_t)((t) + 2) * kstep; const char* b2 = last ? nB : cB + (size_t)((t) + 2) * kstep; \
            const char* a3 = a2 + kstep; const char* b3 = b2 + kstep; \
            PG8_LDB(B0, 0, 0); PG8_LDB(B1, 0, 1); PG8_SCHED; PG8_LDA(At, 0, 0); PG8_STAGE(PG8_SA(1, 1), a1 + hstepA, voffA); \
            PG8_WAIT_V(8); PG8_WAIT_L(0); PG8_BAR; MMAF(0, 0, At, B0); MMAF(0, 1, At, B1); PG8_BAR; PG8_SCHED; \
            PG8_LDA(At, 0, 1); PG8_STAGE(PG8_SB(0, 0), b2, voffB); PG8_STAGE(PG8_SB(0, 1), b2 + hstepB, voffB); PG8_STAGE(PG8_SA(0, 0), a2, voffA); \
            PG8_WAIT_V(8); PG8_WAIT_L(0); PG8_BAR; MMAF(1, 0, At, B0); MMAF(1, 1, At, B1); PG8_BAR; PG8_SCHED; \
            PG8_LDB(B0, 1, 0); PG8_LDB(B1, 1, 1); PG8_SCHED; PG8_LDA(At, 1, 0); PG8_STAGE(PG8_SA(0, 1), a2 + hstepA, voffA); \
            PG8_WAIT_V(8); PG8_WAIT_L(0); PG8_BAR; PG8_MMA(0, 0, At, B0); PG8_MMA(0, 1, At, B1); PG8_BAR; PG8_SCHED; \
            PG8_LDA(At, 1, 1); PG8_STAGE(PG8_SB(1, 0), b3, voffB); PG8_STAGE(PG8_SB(1, 1), b3 + hstepB, voffB); PG8_STAGE(PG8_SA(1, 0), a3, voffA); \
            PG8_WAIT_V(8); PG8_WAIT_L(0); PG8_BAR; PG8_MMA(1, 0, At, B0); PG8_MMA(1, 1, At, B1); PG8_BAR; PG8_SCHED; } while (0)
        PG8_BODY(0, PG8_MMA0);
        for (int t = 2; t < nt; t += 2) PG8_BODY(t, PG8_MMA);
#undef PG8_BODY
        if (wr == 0) PG8_BAR;
        E(acc, cur, wr, wc, lds, ui);
        if (!has_next) break;
        cur = nxt; cA = nA; cB = nB; ++ui;
        if (wr == 1) PG8_BAR;
    }
    PG8_WAIT_V(0);
    PG8_BAR;
#undef PG8_SA
#undef PG8_SB
#undef PG8_STAGE
#undef PG8_LDA
#undef PG8_LDB
#undef PG8_MMA
#undef PG8_MMA0
#undef PG8_WAIT_V
#undef PG8_WAIT_L
#undef PG8_BAR
#undef PG8_SCHED
}

template <class F> struct Epi8 {
    F f;
    __device__ __forceinline__ void prep(LAS unsigned char* lds, const StaticOrder& S, int tid) const {
        if constexpr (F::HAS_PREP) {
            LAS float* tab = (LAS float*)(lds + STAGE_BYTES);
            Unit u;
            for (int i = __builtin_amdgcn_readfirstlane(tid >> 8); i < 8 && S.next(i, u); i += 2) tab[i * 256 + (tid & 255)] = f.rowstat(u.pm * BM + (tid & 255));
            asm volatile("s_waitcnt vmcnt(0) lgkmcnt(0)" ::: "memory");
        }
    }
    __device__ __forceinline__ void operator()(f32x4 (&acc)[2][2][4][2], const Unit& u, int wr, int wc, LAS unsigned char* lds, int ui) const {
        int ln = lane_id(); asm volatile("" : "+v"(ln));
        const int fr = ln & 15, fq = ln >> 4;
        const int colt = u.pn * BM + wc * 32 + 8 * fq;
        const LAS float* tab = (const LAS float*)(lds + STAGE_BYTES) + ui * 256;
        if constexpr (F::HAS_TSTORE) if (f.use_tstore(u.pn)) {
            LAS unsigned char* stg = lds + STAGE_BYTES + (wr * 4 + wc) * 1280;
            const int chl = ln >> 2, part = ln & 3;
#pragma unroll
            for (int ai = 0; ai < 2; ++ai) {
                f32x4 rsv[4]; float rsf[4];
#pragma unroll
                for (int m = 0; m < 4; ++m) { if constexpr (F::HAS_RSLOAD) rsv[m] = f.rs_load(u.pm * BM + ai * HALF + wr * 64 + m * 16 + fr, fq); }
#pragma unroll
                for (int m = 0; m < 4; ++m) { if constexpr (F::HAS_RSLOAD) rsf[m] = f.rs_finish(rsv[m]); else rsf[m] = 1.0f; }
#pragma unroll
                for (int bj = 0; bj < 2; ++bj)
#pragma unroll
                    for (int mp = 0; mp < 2; ++mp)
#pragma unroll
                        for (int n = 0; n < 2; ++n) {
#pragma unroll
                            for (int mm = 0; mm < 2; ++mm)
#pragma unroll
                                for (int e = 0; e < 4; ++e)
                                    *(LAS bf16_t*)(stg + (4 * fq + e) * 80 + (16 * mm + fr) * 2) = (bf16_t)f2bf(acc[ai][bj][2 * mp + mm][n][e] * rsf[2 * mp + mm]);
                            asm volatile("s_waitcnt lgkmcnt(0)" ::: "memory");
                            const u32x4 w = *(const LAS u32x4*)(stg + chl * 80 + part * 16);
                            const int ch = u.pn * BM + bj * HALF + wc * 32 + 8 * (chl >> 2) + 4 * n + (chl & 3);
                            const int tok = u.pm * BM + ai * HALF + wr * 64 + mp * 32 + 8 * part;
                            f.tstore(ch, tok, w);
                            asm volatile("s_waitcnt lgkmcnt(0)" ::: "memory");
                        }
            }
            return;
        }
        u32x4 xr[8][2];
        if constexpr (F::HAS_XLOAD) {
#pragma unroll
            for (int g = 0; g < 4; ++g)
#pragma unroll
                for (int bj = 0; bj < 2; ++bj) xr[g][bj] = f.x_load(u.pm * BM + wr * 64 + g * 16 + (ln >> 2), colt - 8 * fq + 8 * (ln & 3) + bj * HALF);
        }
#pragma unroll
        for (int ai = 0; ai < 2; ++ai) {
            f32x4 rsv[4];
            if constexpr (F::HAS_RSLOAD) {
#pragma unroll
                for (int m = 0; m < 4; ++m) rsv[m] = f.rs_load(u.pm * BM + ai * HALF + wr * 64 + m * 16 + fr, fq);
            }
#pragma unroll
            for (int m = 0; m < 4; ++m) {
                if constexpr (F::HAS_XLOAD) if (ai == 0) {
#pragma unroll
                    for (int bj = 0; bj < 2; ++bj) xr[4 + m][bj] = f.x_load(u.pm * BM + HALF + wr * 64 + m * 16 + (ln >> 2), colt - 8 * fq + 8 * (ln & 3) + bj * HALF);
                }
                const int rl = ai * HALF + wr * 64 + m * 16 + fr;
                const int row = u.pm * BM + rl;
                float rs;
                if constexpr (F::HAS_PREP) rs = tab[rl]; else if constexpr (F::HAS_RSLOAD) rs = f.rs_finish(rsv[m]); else rs = 1.0f;
                float ss = 0.f;
#pragma unroll
                for (int bj = 0; bj < 2; ++bj) {
                    float v[8];
#pragma unroll
                    for (int n = 0; n < 2; ++n)
#pragma unroll
                        for (int e = 0; e < 4; ++e) v[4 * n + e] = acc[ai][bj][m][n][e] * rs;
                    if constexpr (F::HAS_XLOAD) {
                        u32x4 xo = xr[ai * 4 + m][bj]; const int sp = ((fr << 2) | fq) << 2;
                        xo.x = (unsigned)__builtin_amdgcn_ds_bpermute(sp, (int)xo.x); xo.y = (unsigned)__builtin_amdgcn_ds_bpermute(sp, (int)xo.y);
                        xo.z = (unsigned)__builtin_amdgcn_ds_bpermute(sp, (int)xo.z); xo.w = (unsigned)__builtin_amdgcn_ds_bpermute(sp, (int)xo.w);
                        f.store_x(row, colt + bj * HALF, v, ss, xo);
                    } else f.store(row, colt + bj * HALF, v, ss);
                }
                if (F::HAS_SS) { ss += shx(ss, 16); ss += shx(ss, 32); if (fq == 0) f.put_ss(row, u.pn, wc, ss); }
            }
            asm volatile("" ::: "memory");
        }
    }
};
struct EpiSoftmax {
    bf16_t* P; int ldp;
    __device__ __forceinline__ void prep(LAS unsigned char*, const StaticOrder&, int) const {}
    __device__ __forceinline__ void operator()(f32x4 (&acc)[2][2][4][2], const Unit& u, int wr, int wc, LAS unsigned char* lds, int) const {
        int ln = lane_id(); asm volatile("" : "+v"(ln));
        const int fr = ln & 15, fq = ln >> 4;
        LAS float* smax = (LAS float*)(lds + STAGE_BYTES);
        LAS float* ssum = (LAS float*)(lds + STAGE_BYTES + 4096);
#pragma unroll
        for (int ai = 0; ai < 2; ++ai)
#pragma unroll
            for (int m = 0; m < 4; ++m) {
                float mx = acc[ai][0][m][0][0];
#pragma unroll
                for (int bj = 0; bj < 2; ++bj)
#pragma unroll
                    for (int n = 0; n < 2; ++n)
#pragma unroll
                        for (int e = 0; e < 4; ++e) mx = fmaxf(mx, acc[ai][bj][m][n][e]);
                mx = fmaxf(mx, shx(mx, 16)); mx = fmaxf(mx, shx(mx, 32));
                if (fq == 0) smax[(ai * HALF + wr * 64 + m * 16 + fr) * 4 + wc] = mx;
            }
        asm volatile("s_waitcnt lgkmcnt(0)" ::: "memory"); __builtin_amdgcn_s_barrier(); asm volatile("" ::: "memory");
#pragma unroll
        for (int ai = 0; ai < 2; ++ai)
#pragma unroll
            for (int m = 0; m < 4; ++m) {
                const int rl = ai * HALF + wr * 64 + m * 16 + fr;
                const f32x4 t = *(const LAS f32x4*)(smax + rl * 4);
                const float mx = fmaxf(fmaxf(t.x, t.y), fmaxf(t.z, t.w));
                float sm = 0.f;
#pragma unroll
                for (int bj = 0; bj < 2; ++bj)
#pragma unroll
                    for (int n = 0; n < 2; ++n)
#pragma unroll
                        for (int e = 0; e < 4; ++e) { const float p = __builtin_amdgcn_exp2f(acc[ai][bj][m][n][e] - mx); acc[ai][bj][m][n][e] = p; sm += p; }
                sm += shx(sm, 16); sm += shx(sm, 32);
                if (fq == 0) ssum[rl * 4 + wc] = sm;
            }
        asm volatile("s_waitcnt lgkmcnt(0)" ::: "memory"); __builtin_amdgcn_s_barrier(); asm volatile("" ::: "memory");
        const int colt = u.pn * BM + wc * 32 + 8 * fq;
#pragma unroll
        for (int ai = 0; ai < 2; ++ai)
#pragma unroll
            for (int m = 0; m < 4; ++m) {
                const int rl = ai * HALF + wr * 64 + m * 16 + fr;
                const f32x4 t = *(const LAS f32x4*)(ssum + rl * 4);
                const float inv = 1.0f / ((t.x + t.y) + (t.z + t.w));
#pragma unroll
                for (int bj = 0; bj < 2; ++bj) {
                    float v[8];
#pragma unroll
                    for (int n = 0; n < 2; ++n)
#pragma unroll
                        for (int e = 0; e < 4; ++e) v[4 * n + e] = acc[ai][bj][m][n][e] * inv;
                    st16_rows(P, (size_t)ldp, u.pm * BM + rl, colt + bj * HALF, pack8(v));
                }
            }
        asm volatile("s_waitcnt lgkmcnt(0)" ::: "memory");
    }
};
}

__device__ __forceinline__ size_t rss_idx(int row, int slot) { return ((size_t)(row >> 4) << 8) + (slot << 4) + (row & 15); }
__device__ __forceinline__ f32x4 rss_ld4(const float* RSS, int row, int q4) { const float* p = RSS + rss_idx(row, 4 * q4); return (f32x4){p[0], p[16], p[32], p[48]}; }
__device__ __forceinline__ float xnorm_full(const float* RSS, int row) {
    const f32x4 a = rss_ld4(RSS, row, 0), b = rss_ld4(RSS, row, 1), c = rss_ld4(RSS, row, 2), d = rss_ld4(RSS, row, 3);
    const float s = (((a.x + a.y) + (a.z + a.w)) + ((b.x + b.y) + (b.z + b.w))) + (((c.x + c.y) + (c.z + c.w)) + ((d.x + d.y) + (d.z + d.w)));
    return __builtin_amdgcn_rsqf(s * (1.0f / DM) + EPS);
}
__device__ __forceinline__ float xnorm_scale(const float* RSS, int row, int fq) {
    const f32x4 t = rss_ld4(RSS, row, fq);
    float s = (t.x + t.y) + (t.z + t.w);
    s += shx(s, 16); s += shx(s, 32);
    return __builtin_amdgcn_rsqf(s * (1.0f / DM) + EPS);
}
template <int DIM> __device__ __forceinline__ void rope8(float (&v)[8], int pos, int i0) {
    const float fpos = (float)pos * 0.15915494309189535f;
#pragma unroll
    for (int j = 0; j < 4; ++j) {
        const float invf = __builtin_amdgcn_exp2f((float)(i0 + j) * (-2.0f * 13.287712379549449f / (float)DIM));
        const float rev = __builtin_amdgcn_fractf(fpos * invf);
        const float c = __builtin_amdgcn_cosf(rev), sn = __builtin_amdgcn_sinf(rev);
        const float a = v[2 * j], b = v[2 * j + 1]; v[2 * j] = a * c - b * sn; v[2 * j + 1] = b * c + a * sn;
    }
}
struct EpiIn {
    static constexpr bool HAS_SS = true, HAS_PREP = false, HAS_RSLOAD = true, HAS_XLOAD = false, HAS_TSTORE = true;
    static constexpr int TSTORE_PN = 6;
    __device__ __forceinline__ bool use_tstore(int pn) const { return pn < TSTORE_PN; }
    const float* RSS; bf16_t* HYT; bf16_t* LAT; float* LSS; bf16_t* KM;
    __device__ __forceinline__ void tstore(int ch, int tok, u32x4 w) const { *(u32x4*)(HYT + (size_t)ch * T_TOK + tok) = w; }
    __device__ __forceinline__ float rowstat(int row) const { return xnorm_full(RSS, row); }
    __device__ __forceinline__ f32x4 rs_load(int row, int fq) const { return rss_ld4(RSS, row, fq); }
    __device__ __forceinline__ float rs_finish(f32x4 t) const { float s_ = (t.x + t.y) + (t.z + t.w); s_ += shx(s_, 16); s_ += shx(s_, 32); return __builtin_amdgcn_rsqf(s_ * (1.0f / DM) + EPS); }
    __device__ __forceinline__ void store(int row, int col0, float (&v)[8], float& ss) const {
        if (col0 < 1536) {
#pragma unroll
            for (int j = 0; j < 8; ++j) HYT[(size_t)(col0 + j) * T_TOK + row] = (bf16_t)f2bf(v[j]);
        } else if (col0 < 1920) {
            st16_rows(LAT, (size_t)384, row, col0 - 1536, pack8(v));
#pragma unroll
            for (int j = 0; j < 8; ++j) ss += v[j] * v[j];
        } else if (col0 < 1952) {
            rope8<32>(v, row & (SEQ - 1), (col0 - 1920) >> 1);
            const u32x4 w = pack8(v);
#pragma unroll
            for (int h = 0; h < 8; ++h) *(u32x4*)(KM + (size_t)row * 768 + h * 96 + 64 + (col0 - 1920)) = w;
        }
    }
    __device__ __forceinline__ void put_ss(int row, int pn, int wc, float ss) const {
        if (pn == 6) LSS[(size_t)row * 8 + wc] = ss; else if (pn == 7) LSS[(size_t)row * 8 + 4 + wc] = ss;
    }
};
struct EpiUq {
    static constexpr bool HAS_SS = false, HAS_PREP = false, HAS_RSLOAD = true, HAS_XLOAD = false, HAS_TSTORE = false;
    const float* LSS; bf16_t* QM;
    __device__ __forceinline__ f32x4 rs_load(int row, int) const { return *(const f32x4*)(LSS + (size_t)row * 8); }
    __device__ __forceinline__ float rs_finish(f32x4 t) const { return __builtin_amdgcn_rsqf(((t.x + t.y) + (t.z + t.w)) * (1.0f / 256) + EPS) * (0.10206207261596577f * LOG2E); }
    __device__ __forceinline__ void store(int row, int col0, float (&v)[8], float&) const {
        const int j = col0 % 96;
        if (j >= 64) rope8<32>(v, row & (SEQ - 1), (j - 64) >> 1);
        st16_rows(QM, (size_t)768, row, col0, pack8(v));
    }
    __device__ __forceinline__ void put_ss(int, int, int, float) const {}
};
struct EpiUkv {
    static constexpr bool HAS_SS = false, HAS_PREP = false, HAS_RSLOAD = true, HAS_XLOAD = false, HAS_TSTORE = false;
    const float* LSS; bf16_t* KM; bf16_t* VM;
    __device__ __forceinline__ f32x4 rs_load(int row, int) const { return *(const f32x4*)(LSS + (size_t)row * 8 + 4); }
    __device__ __forceinline__ float rs_finish(f32x4 t) const { return __builtin_amdgcn_rsqf(((t.x + t.y) + (t.z + t.w)) * (1.0f / 128) + EPS); }
    __device__ __forceinline__ void store(int row, int col0, float (&v)[8], float&) const {
        const int h = col0 >> 7, j = col0 & 127;
        if (j < 64) st16_rows(KM, (size_t)768, row, h * 96 + j, pack8(v));
        else st16_rows(VM, (size_t)512, row, h * 64 + (j - 64), pack8(v));
    }
    __device__ __forceinline__ void put_ss(int, int, int, float) const {}
};
struct EpiRes {
    static constexpr bool HAS_SS = true, HAS_PREP = false, HAS_RSLOAD = false, HAS_XLOAD = true, HAS_TSTORE = false;
    const bf16_t* XBI; bf16_t* XB; float* RSS;
    __device__ __forceinline__ u32x4 x_load(int row, int col0) const { return *(const u32x4*)(XBI + (size_t)row * DM + col0); }
    __device__ __forceinline__ void store_x(int row, int col0, float (&v)[8], float& ss, u32x4 xo) const {
        const size_t off = (size_t)row * DM + col0;
        v[0] += __builtin_bit_cast(float, xo.x << 16); v[1] += __builtin_bit_cast(float, xo.x & 0xffff0000u);
        v[2] += __builtin_bit_cast(float, xo.y << 16); v[3] += __builtin_bit_cast(float, xo.y & 0xffff0000u);
        v[4] += __builtin_bit_cast(float, xo.z << 16); v[5] += __builtin_bit_cast(float, xo.z & 0xffff0000u);
        v[6] += __builtin_bit_cast(float, xo.w << 16); v[7] += __builtin_bit_cast(float, xo.w & 0xffff0000u);
        const u32x4 w = pack8(v);
        st16_rows(XB, (size_t)DM, row, col0, w);
        const float r0 = __builtin_bit_cast(float, w.x << 16), r1 = __builtin_bit_cast(float, w.x & 0xffff0000u), r2 = __builtin_bit_cast(float, w.y << 16), r3 = __builtin_bit_cast(float, w.y & 0xffff0000u);
        const float r4 = __builtin_bit_cast(float, w.z << 16), r5 = __builtin_bit_cast(float, w.z & 0xffff0000u), r6 = __builtin_bit_cast(float, w.w << 16), r7 = __builtin_bit_cast(float, w.w & 0xffff0000u);
        ss += ((r0 * r0 + r1 * r1) + (r2 * r2 + r3 * r3)) + ((r4 * r4 + r5 * r5) + (r6 * r6 + r7 * r7));
    }
    __device__ __forceinline__ void store(int, int, float (&)[8], float&) const {}
    __device__ __forceinline__ void put_ss(int row, int pn, int wc, float ss) const { RSS[rss_idx(row, pn * 4 + wc)] = ss; }
};
struct EpiNormBf16 {
    static constexpr bool HAS_SS = false, HAS_PREP = true, HAS_RSLOAD = false, HAS_XLOAD = false, HAS_TSTORE = false;
    const float* RSS; bf16_t* O; int ldo; float extra;
    __device__ __forceinline__ float rowstat(int row) const { return xnorm_full(RSS, row) * extra; }
    __device__ __forceinline__ float rowscale(int, int) const { return 1.0f; }
    __device__ __forceinline__ void store(int row, int col0, float (&v)[8], float&) const { st16_rows(O, (size_t)ldo, row, col0, pack8(v)); }
    __device__ __forceinline__ void put_ss(int, int, int, float) const {}
};
struct EpiUp {
    static constexpr bool HAS_SS = false, HAS_PREP = true, HAS_RSLOAD = false, HAS_XLOAD = false, HAS_TSTORE = false;
    const float* RSS; bf16_t* O;
    __device__ __forceinline__ float rowstat(int row) const { return xnorm_full(RSS, row); }
    __device__ __forceinline__ float rowscale(int, int) const { return 1.0f; }
    __device__ __forceinline__ void store(int row, int col0, float (&v)[8], float&) const {
#pragma unroll
        for (int j = 0; j < 8; ++j) { const float t = fmaxf(v[j], 0.f); v[j] = t * t; }
        st16_rows_nt(O, (size_t)DFF, row, col0, pack8(v));
    }
    __device__ __forceinline__ void put_ss(int, int, int, float) const {}
};
struct EpiQkv {
    static constexpr bool HAS_SS = false, HAS_PREP = true, HAS_RSLOAD = false, HAS_XLOAD = false, HAS_TSTORE = false;
    const float* RSS; bf16_t* O;
    __device__ __forceinline__ float rowstat(int row) const { return xnorm_full(RSS, row); }
    __device__ __forceinline__ float rowscale(int, int) const { return 1.0f; }
    __device__ __forceinline__ void store(int row, int col0, float (&v)[8], float&) const {
        if (col0 < 2048) {
            rope8<64>(v, row & (SEQ - 1), (col0 & 63) >> 1);
            if (col0 < 1024) {
#pragma unroll
                for (int j = 0; j < 8; ++j) v[j] *= 0.125f * LOG2E;
            }
        }
        st16_rows_nt(O, (size_t)3072, row, col0, pack8(v));
    }
    __device__ __forceinline__ void put_ss(int, int, int, float) const {}
};
struct EpiPlain {
    static constexpr bool HAS_SS = false, HAS_PREP = false, HAS_RSLOAD = false, HAS_XLOAD = false, HAS_TSTORE = false;
    bf16_t* O; int ldo;
    __device__ __forceinline__ float rowscale(int, int) const { return 1.0f; }
    __device__ __forceinline__ void store(int row, int col0, float (&v)[8], float&) const { st16_rows(O, (size_t)ldo, row, col0, pack8(v)); }
    __device__ __forceinline__ void put_ss(int, int, int, float) const {}
};
struct EpiMemKV {
    static constexpr bool HAS_SS = false, HAS_PREP = false, HAS_RSLOAD = false, HAS_XLOAD = false, HAS_TSTORE = true;
    bf16_t* MEMK; bf16_t* VT;
    __device__ __forceinline__ bool use_tstore(int pn) const { return (pn & 7) >= 4; }
    __device__ __forceinline__ f32x4 rs_load(int, int) const { return (f32x4){0.f, 0.f, 0.f, 0.f}; }
    __device__ __forceinline__ float rs_finish(f32x4) const { return 1.0f; }
    __device__ __forceinline__ void tstore(int ch, int tok, u32x4 w) const {
        const int l = ch >> 11, hd = (ch & 2047) - 1024, b = tok >> 8, key = tok & 255;
        *(u32x4*)(VT + ((size_t)(l * NB + b) * 1024 + hd) * 256 + key) = w;
    }
    __device__ __forceinline__ float rowscale(int, int) const { return 1.0f; }
    __device__ __forceinline__ void store(int row, int col0, float (&v)[8], float&) const {
        const int l = col0 >> 11, rem = col0 & 2047;
        if (rem < 1024) st16_rows(MEMK, (size_t)2048, row, l * 1024 + rem, pack8(v));
        else {
            const int hd = rem - 1024, b = row >> 8, key = row & 255;
            bf16_t* dst = VT + ((size_t)(l * NB + b) * 1024 + hd) * 256 + key;
#pragma unroll
            for (int j = 0; j < 8; ++j) dst[j * 256] = (bf16_t)f2bf(v[j]);
        }
    }
    __device__ __forceinline__ void put_ss(int, int, int, float) const {}
};

template <class F>
__device__ __forceinline__ void run_gemm(LAS unsigned char* lds, int wave0, const bf16_t* A, int lda, const bf16_t* Bt, int ldb, int M, int N, int K, const F& f) {
    pg8::Gemm g{A, Bt, M, N, K, lda, ldb};
    pg8::StaticOrder S; S.init(M, N, (int)gridDim.x, (int)blockIdx.x);
    pg8::Epi8<F> E{f};
    pg8::AddrStd AD{(const char*)A, (const char*)Bt, (size_t)256 * lda * 2, (size_t)256 * ldb * 2};
    pg8::gemm_phase<pg8::Epi8<F>, pg8::AddrStd>(lds, wave0, g, S, E, AD);
}
template <class Epi, class Addr>
__device__ __forceinline__ void run_gemm_ad(LAS unsigned char* lds, int wave0, int lda, int ldb, int M, int N, int K, const Epi& E, const Addr& AD) {
    pg8::Gemm g{nullptr, nullptr, M, N, K, lda, ldb};
    pg8::StaticOrder S; S.init(M, N, (int)gridDim.x, (int)blockIdx.x);
    pg8::gemm_phase<Epi, Addr>(lds, wave0, g, S, E, AD);
}
struct AddrXS {
    const char* Q; const char* Kmem;
    __device__ __forceinline__ const char* a(const pg8::Unit& u) const { return Q + ((size_t)u.pm * 256 * DM + u.pn * 256) * 2; }
    __device__ __forceinline__ const char* b(const pg8::Unit& u) const { return Kmem + ((size_t)(u.pm >> 3) * NMEM * 2048 + u.pn * 256) * 2; }
};
struct AddrXV {
    const char* Pm; const char* VT;
    __device__ __forceinline__ const char* a(const pg8::Unit& u) const { return Pm + ((size_t)u.pm * 256 * DM + u.pn * 256) * 2; }
    __device__ __forceinline__ const char* b(const pg8::Unit& u) const { return VT + ((size_t)((u.pm >> 3) * 4 + u.pn) * 65536) * 2; }
};

template <int MODE> struct ACfg;
template <> struct ACfg<0> { static constexpr int KW = 96, NQK = 6, VW = 64, NVB = 2, NRG = 8, NT = 32; };
template <> struct ACfg<1> { static constexpr int KW = 128, NQK = 4, VW = 128, NVB = 4, NRG = 4, NT = 32; };
template <> struct ACfg<2> { static constexpr int KW = 256, NQK = 16, VW = 256, NVB = 4, NRG = 4, NT = 4; };

__device__ __forceinline__ int crow(int r, int hi) { return (r & 3) + 8 * (r >> 2) + 4 * hi; }
template <int NCB> __device__ __forceinline__ int v_st(int k, int c) { const int kk = (k & ~0xC) | ((k & 4) << 1) | ((k & 8) >> 1); return ((kk >> 3) * NCB + (c >> 5)) * 512 + ((kk & 7) * 32 + (c & 31)) * 2; }
__device__ __forceinline__ int v_rd_base(int lane) { return ((lane & 3) << 3) | (((lane >> 2) & 3) << 6) | (((lane >> 4) & 1) << 5) | (((lane >> 5) & 1) << 8); }
template <int NCB> __device__ __forceinline__ int v_rd_base2(int lane) { return ((lane & 3) << 3) | (((lane >> 2) & 3) << 6) | (((lane >> 4) & 1) << 5) | (((lane >> 5) & 1) * (NCB * 512)); }
template <int OFF> __device__ __forceinline__ s16x4 tr_read(int vb) { s16x4 r; asm volatile("ds_read_b64_tr_b16 %0, %1 offset:%2" : "=&v"(r) : "v"(vb), "i"(OFF) : "memory"); return r; }
template <int NCB, int D0> __device__ __forceinline__ void pv_one(f32x16& od, int vb, bf16x8 pa0, bf16x8 pa1, bf16x8 pa2, bf16x8 pa3) {
    constexpr int KS = 2 * NCB * 512, HF = NCB * 512, B0 = D0 * 512;
    const s16x4 l0 = tr_read<B0>(vb), h0 = tr_read<B0 + HF>(vb), l1 = tr_read<B0 + KS>(vb), h1 = tr_read<B0 + KS + HF>(vb);
    const s16x4 l2 = tr_read<B0 + 2 * KS>(vb), h2 = tr_read<B0 + 2 * KS + HF>(vb), l3 = tr_read<B0 + 3 * KS>(vb), h3 = tr_read<B0 + 3 * KS + HF>(vb);
    asm volatile("s_waitcnt lgkmcnt(0)" ::: "memory"); __builtin_amdgcn_sched_barrier(0);
#define PK(L, H) (bf16x8){L[0], L[1], L[2], L[3], H[0], H[1], H[2], H[3]}
    od = __builtin_amdgcn_mfma_f32_32x32x16_bf16(pa0, PK(l0, h0), od, 0, 0, 0);
    od = __builtin_amdgcn_mfma_f32_32x32x16_bf16(pa1, PK(l1, h1), od, 0, 0, 0);
    od = __builtin_amdgcn_mfma_f32_32x32x16_bf16(pa2, PK(l2, h2), od, 0, 0, 0);
    od = __builtin_amdgcn_mfma_f32_32x32x16_bf16(pa3, PK(l3, h3), od, 0, 0, 0);
#undef PK
}

struct AttnIO { const bf16_t* Q; int ldq; const bf16_t* K; int ldk; const bf16_t* V; int ldv; bf16_t* O; int ldo; float lam; };

template <int MODE>
__device__ __forceinline__ void attn_unit(char* lds, int wave0, const AttnIO io) {
    using C = ACfg<MODE>;
    constexpr int KW = C::KW, NQK = C::NQK, VW = C::VW, NVB = C::NVB, NRG = C::NRG, NT = C::NT;
    constexpr int KSTR = KW * 2 + 16, KBUF = 64 * KSTR, NCB = VW / 32, VBUF = 64 * VW * 2;
    constexpr int KCPR = KW / 8, KCH = 64 * KCPR, KPASS = (KCH + 511) / 512, VCPR = VW / 8, VCH = 64 * VCPR, VPASS = VCH / 512;
    constexpr int OFF_V = 2 * KBUF, OFF_WS = 2 * KBUF + 2 * VBUF;
    static_assert(OFF_WS + NWAVES * 256 <= LDS_BYTES, "attention LDS");
    int tid_ = wave0 * 64 + lane_id(); asm volatile("" : "+v"(tid_));
    const int tid = tid_, lane = tid & 63, r32 = lane & 31, hi = lane >> 5;
    const int wid = __builtin_amdgcn_readfirstlane(tid >> 6);
    const int rg = wid % NRG, part = wid / NRG;
    char* K_lds = lds; char* V_lds = lds + OFF_V;
    float* wsf = (float*)(lds + OFF_WS) + wid * 64;
    const int qk0 = (MODE == 1) ? 4 * part : 0;
    const int vb0 = (MODE == 2) ? 4 * part : 0;
    bf16x8 qr[NQK];
    {
        const bf16_t* Qw = io.Q + (size_t)(rg * 32 + r32) * io.ldq + ((MODE == 1) ? 64 * part : 0) + hi * 8;
#pragma unroll
        for (int s = 0; s < NQK; ++s) qr[s] = *(const bf16x8*)(Qw + s * 16);
    }
    f32x16 o[NVB];
#pragma unroll
    for (int d = 0; d < NVB; ++d) o[d] = f32x16{};
    float m_reg = -1e30f, l_reg = 0.f;
    bf16x8 ks_[KPASS], vs_[VPASS];
#define A_SLOAD(t) do { const int k0_ = (t) * 64; \
        _Pragma("unroll") for (int i_ = 0; i_ < KPASS; ++i_) { const int id_ = tid + 512 * i_; if (KCH % 512 == 0 || id_ < KCH) ks_[i_] = *(const bf16x8*)(io.K + (size_t)(k0_ + id_ / KCPR) * io.ldk + (id_ % KCPR) * 8); } \
        _Pragma("unroll") for (int i_ = 0; i_ < VPASS; ++i_) { const int id_ = tid + 512 * i_; vs_[i_] = *(const bf16x8*)(io.V + (size_t)(k0_ + id_ / VCPR) * io.ldv + (id_ % VCPR) * 8); } } while (0)
#define A_SWRITE(b) do { \
        _Pragma("unroll") for (int i_ = 0; i_ < KPASS; ++i_) { const int id_ = tid + 512 * i_; if (KCH % 512 == 0 || id_ < KCH) *(bf16x8*)(K_lds + (b) * KBUF + (id_ / KCPR) * KSTR + (id_ % KCPR) * 16) = ks_[i_]; } \
        _Pragma("unroll") for (int i_ = 0; i_ < VPASS; ++i_) { const int id_ = tid + 512 * i_; *(bf16x8*)(V_lds + (b) * VBUF + v_st<NCB>(id_ / VCPR, (id_ % VCPR) * 8)) = vs_[i_]; } } while (0)
    A_SLOAD(0); A_SWRITE(0); __syncthreads();
    const int vbase = (int)(uintptr_t)V_lds + v_rd_base(lane) + vb0 * 512;
    for (int j = 0; j < NT; ++j) {
        const int buf = j & 1;
        if (j + 1 < NT) A_SLOAD(j + 1);
        f32x16 p0 = f32x16{}, p1 = f32x16{};
        {
            const char* kb = K_lds + buf * KBUF + r32 * KSTR + (qk0 * 16 + hi * 8) * 2;
#pragma unroll
            for (int s = 0; s < NQK; ++s) {
                const bf16x8 b0 = *(const bf16x8*)(kb + s * 32);
                const bf16x8 b1 = *(const bf16x8*)(kb + 32 * KSTR + s * 32);
                p0 = __builtin_amdgcn_mfma_f32_32x32x16_bf16(b0, qr[s], p0, 0, 0, 0);
                p1 = __builtin_amdgcn_mfma_f32_32x32x16_bf16(b1, qr[s], p1, 0, 0, 0);
            }
        }
        float pmax = p0[0];
#pragma unroll
        for (int r = 1; r < 16; ++r) pmax = fmaxf(pmax, p0[r]);
#pragma unroll
        for (int r = 0; r < 16; ++r) pmax = fmaxf(pmax, p1[r]);
        { auto rr = __builtin_amdgcn_permlane32_swap(__float_as_uint(pmax), __float_as_uint(pmax), false, false); pmax = fmaxf(__uint_as_float(rr[0]), __uint_as_float(rr[1])); }
        const float mn = fmaxf(m_reg, pmax);
        const float alpha = __builtin_amdgcn_exp2f(m_reg - mn);
        m_reg = mn;
#pragma unroll
        for (int r = 0; r < 16; ++r) { p0[r] = __builtin_amdgcn_exp2f(p0[r] - mn); p1[r] = __builtin_amdgcn_exp2f(p1[r] - mn); }
        float ps = 0.f;
#pragma unroll
        for (int r = 0; r < 16; ++r) ps += p0[r];
#pragma unroll
        for (int r = 0; r < 16; ++r) ps += p1[r];
        { auto rr = __builtin_amdgcn_permlane32_swap(__float_as_uint(ps), __float_as_uint(ps), false, false); ps = __uint_as_float(rr[0]) + __uint_as_float(rr[1]); }
        l_reg = l_reg * alpha + ps;
        bf16x8 pa0, pa1, pa2, pa3;
#define PK4(P, BASE, OUT) do { unsigned a0 = cvt_pk_bf16(P[BASE + 0], P[BASE + 1]), a1 = cvt_pk_bf16(P[BASE + 2], P[BASE + 3]); \
        unsigned b0 = cvt_pk_bf16(P[BASE + 4], P[BASE + 5]), b1 = cvt_pk_bf16(P[BASE + 6], P[BASE + 7]); \
        auto r0 = __builtin_amdgcn_permlane32_swap(a0, b0, false, false); auto r1 = __builtin_amdgcn_permlane32_swap(a1, b1, false, false); \
        u32x4 w = {r0[0], r1[0], r0[1], r1[1]}; OUT = __builtin_bit_cast(bf16x8, w); } while (0)
        PK4(p0, 0, pa0); PK4(p0, 8, pa1); PK4(p1, 0, pa2); PK4(p1, 8, pa3);
#undef PK4
        if (__any(alpha < 1.f)) {
            if (hi == 0) wsf[r32] = alpha;
            asm volatile("s_waitcnt lgkmcnt(0)" ::: "memory");
#pragma unroll
            for (int r = 0; r < 16; ++r) { const float a = wsf[crow(r, hi)];
#pragma unroll
                for (int d = 0; d < NVB; ++d) o[d][r] *= a; }
        }
        {
            const int vb = vbase + buf * VBUF;
            pv_one<NCB, 0>(o[0], vb, pa0, pa1, pa2, pa3);
            pv_one<NCB, 1>(o[1], vb, pa0, pa1, pa2, pa3);
            if constexpr (NVB == 4) { pv_one<NCB, 2>(o[2], vb, pa0, pa1, pa2, pa3); pv_one<NCB, 3>(o[3], vb, pa0, pa1, pa2, pa3); }
        }
        if (j + 1 < NT) A_SWRITE(buf ^ 1);
        __syncthreads();
    }
#undef A_SLOAD
#undef A_SWRITE
    if (hi == 0) wsf[32 + r32] = l_reg;
    asm volatile("s_waitcnt lgkmcnt(0)" ::: "memory");
    float rli[16];
#pragma unroll
    for (int r = 0; r < 16; ++r) rli[r] = 1.0f / wsf[32 + crow(r, hi)];
    if constexpr (MODE == 1) {
        constexpr int XS = 132;
        float* X = (float*)lds;
        if (part == 1) {
#pragma unroll
            for (int r = 0; r < 16; ++r) { const int row = rg * 32 + crow(r, hi);
#pragma unroll
                for (int d = 0; d < NVB; ++d) X[row * XS + d * 32 + r32] = o[d][r] * rli[r]; }
        }
        __syncthreads();
        if (part == 0) {
#pragma unroll
            for (int r = 0; r < 16; ++r) { const int row = rg * 32 + crow(r, hi);
                float ss = 0.f;
#pragma unroll
                for (int d = 0; d < NVB; ++d) { const float t = o[d][r] * rli[r] - io.lam * X[row * XS + d * 32 + r32]; o[d][r] = t; ss += t * t; }
                ss += shx(ss, 1); ss += shx(ss, 2); ss += shx(ss, 4); ss += shx(ss, 8); ss += shx(ss, 16);
                const float rn = __builtin_amdgcn_rsqf(ss * (1.0f / 128) + SUBLN_EPS);
#pragma unroll
                for (int d = 0; d < NVB; ++d) io.O[(size_t)row * io.ldo + d * 32 + r32] = (bf16_t)f2bf(o[d][r] * rn);
            }
        }
        __syncthreads();
    } else {
#pragma unroll
        for (int r = 0; r < 16; ++r) { const int row = rg * 32 + crow(r, hi);
#pragma unroll
            for (int d = 0; d < NVB; ++d) io.O[(size_t)row * io.ldo + (vb0 + d) * 32 + r32] = (bf16_t)f2bf(o[d][r] * rli[r]); }
    }
}

__device__ __forceinline__ float vmax3(float a, float b, float c) { float d; asm("v_max3_f32 %0, %1, %2, %3" : "=v"(d) : "v"(a), "v"(b), "v"(c)); return d; }
__device__ __forceinline__ float vmax2(float a, float b) { float d; asm("v_max_f32 %0, %1, %2" : "=v"(d) : "v"(a), "v"(b)); return d; }
constexpr float ATT_THR = 8.0f;
__device__ __forceinline__ void att_partialSM(f32x16& p0, f32x16& p1, float& m_reg, float& alpha) {
    float pmax = p0[0];
#pragma unroll
    for (int r = 1; r < 16; ++r) pmax = fmaxf(pmax, p0[r]);
#pragma unroll
    for (int r = 0; r < 16; ++r) pmax = fmaxf(pmax, p1[r]);
    { auto rr = __builtin_amdgcn_permlane32_swap(__float_as_uint(pmax), __float_as_uint(pmax), false, false); pmax = fmaxf(__uint_as_float(rr[0]), __uint_as_float(rr[1])); }
    float mn;
    if (__builtin_expect(__all(pmax - m_reg <= ATT_THR), 1)) { mn = m_reg; alpha = 1.f; }
    else { mn = fmaxf(m_reg, pmax); alpha = __builtin_amdgcn_exp2f(m_reg - mn); m_reg = mn; }
#pragma unroll
    for (int r = 0; r < 16; ++r) p0[r] = __builtin_amdgcn_exp2f(p0[r] - mn);
#pragma unroll
    for (int r = 0; r < 16; ++r) p1[r] = p1[r] - mn;
}
__device__ __forceinline__ void att_finishSM(f32x16& p0, f32x16& p1, float alpha, float& l_reg, bf16x8& pa0, bf16x8& pa1, bf16x8& pa2, bf16x8& pa3) {
#pragma unroll
    for (int r = 0; r < 16; ++r) p1[r] = __builtin_amdgcn_exp2f(p1[r]);
    float ps = 0.f;
#pragma unroll
    for (int r = 0; r < 16; ++r) ps += p0[r];
#pragma unroll
    for (int r = 0; r < 16; ++r) ps += p1[r];
    { auto rr = __builtin_amdgcn_permlane32_swap(__float_as_uint(ps), __float_as_uint(ps), false, false); ps = __uint_as_float(rr[0]) + __uint_as_float(rr[1]); }
    l_reg = l_reg * alpha + ps;
#define PK4(P, BASE, OUT) do { unsigned a0 = cvt_pk_bf16(P[BASE + 0], P[BASE + 1]), a1 = cvt_pk_bf16(P[BASE + 2], P[BASE + 3]); \
    unsigned b0 = cvt_pk_bf16(P[BASE + 4], P[BASE + 5]), b1 = cvt_pk_bf16(P[BASE + 6], P[BASE + 7]); \
    auto r0 = __builtin_amdgcn_permlane32_swap(a0, b0, false, false); auto r1 = __builtin_amdgcn_permlane32_swap(a1, b1, false, false); \
    u32x4 w = {r0[0], r1[0], r0[1], r1[1]}; OUT = __builtin_bit_cast(bf16x8, w); } while (0)
    PK4(p0, 0, pa0); PK4(p0, 8, pa1); PK4(p1, 0, pa2); PK4(p1, 8, pa3);
#undef PK4
}
struct VFrag { s16x4 l0, h0, l1, h1, l2, h2, l3, h3; };
template <int NCB, int D> __device__ __forceinline__ void vfrag_read(VFrag& f, int vb) {
    constexpr int KS = 2 * NCB * 512, HF = 256;
    f.l0 = tr_read<D * 512>(vb); f.h0 = tr_read<D * 512 + HF>(vb); f.l1 = tr_read<D * 512 + KS>(vb); f.h1 = tr_read<D * 512 + KS + HF>(vb);
    f.l2 = tr_read<D * 512 + 2 * KS>(vb); f.h2 = tr_read<D * 512 + 2 * KS + HF>(vb); f.l3 = tr_read<D * 512 + 3 * KS>(vb); f.h3 = tr_read<D * 512 + 3 * KS + HF>(vb);
}
__device__ __forceinline__ void att_finishSM2(f32x16& p0, f32x16& p1, float alpha, float& l_reg, bf16x8& pa0, bf16x8& pa1, bf16x8& pa2, bf16x8& pa3) {
#pragma unroll
    for (int r = 0; r < 16; ++r) p1[r] = __builtin_amdgcn_exp2f(p1[r]);
    float ps = 0.f;
#pragma unroll
    for (int r = 0; r < 16; ++r) ps += p0[r];
#pragma unroll
    for (int r = 0; r < 16; ++r) ps += p1[r];
    { auto rr = __builtin_amdgcn_permlane32_swap(__float_as_uint(ps), __float_as_uint(ps), false, false); ps = __uint_as_float(rr[0]) + __uint_as_float(rr[1]); }
    l_reg = l_reg * alpha + ps;
#define PK4N(P, BASE, OUT) do { u32x4 w = {cvt_pk_bf16(P[BASE + 0], P[BASE + 1]), cvt_pk_bf16(P[BASE + 2], P[BASE + 3]), cvt_pk_bf16(P[BASE + 4], P[BASE + 5]), cvt_pk_bf16(P[BASE + 6], P[BASE + 7])}; OUT = __builtin_bit_cast(bf16x8, w); } while (0)
    PK4N(p0, 0, pa0); PK4N(p0, 8, pa1); PK4N(p1, 0, pa2); PK4N(p1, 8, pa3);
#undef PK4N
}
template <int NCB, int NVB> __device__ __forceinline__ void att_pv2(f32x16 (&o)[NVB], int vb, bf16x8 pa0, bf16x8 pa1, bf16x8 pa2, bf16x8 pa3) {
#define PK(L, H) (bf16x8){L[0], L[1], L[2], L[3], H[0], H[1], H[2], H[3]}
    VFrag f;
    vfrag_read<NCB, 0>(f, vb); asm volatile("s_waitcnt lgkmcnt(0)" ::: "memory"); __builtin_amdgcn_sched_barrier(0);
    o[0] = __builtin_amdgcn_mfma_f32_32x32x16_bf16(pa0, PK(f.l0, f.h0), o[0], 0, 0, 0); o[0] = __builtin_amdgcn_mfma_f32_32x32x16_bf16(pa1, PK(f.l1, f.h1), o[0], 0, 0, 0);
    o[0] = __builtin_amdgcn_mfma_f32_32x32x16_bf16(pa2, PK(f.l2, f.h2), o[0], 0, 0, 0); o[0] = __builtin_amdgcn_mfma_f32_32x32x16_bf16(pa3, PK(f.l3, f.h3), o[0], 0, 0, 0);
    vfrag_read<NCB, 1>(f, vb); asm volatile("s_waitcnt lgkmcnt(0)" ::: "memory"); __builtin_amdgcn_sched_barrier(0);
    o[1] = __builtin_amdgcn_mfma_f32_32x32x16_bf16(pa0, PK(f.l0, f.h0), o[1], 0, 0, 0); o[1] = __builtin_amdgcn_mfma_f32_32x32x16_bf16(pa1, PK(f.l1, f.h1), o[1], 0, 0, 0);
    o[1] = __builtin_amdgcn_mfma_f32_32x32x16_bf16(pa2, PK(f.l2, f.h2), o[1], 0, 0, 0); o[1] = __builtin_amdgcn_mfma_f32_32x32x16_bf16(pa3, PK(f.l3, f.h3), o[1], 0, 0, 0);
    if constexpr (NVB == 4) {
        vfrag_read<NCB, 2>(f, vb); asm volatile("s_waitcnt lgkmcnt(0)" ::: "memory"); __builtin_amdgcn_sched_barrier(0);
        o[2] = __builtin_amdgcn_mfma_f32_32x32x16_bf16(pa0, PK(f.l0, f.h0), o[2], 0, 0, 0); o[2] = __builtin_amdgcn_mfma_f32_32x32x16_bf16(pa1, PK(f.l1, f.h1), o[2], 0, 0, 0);
        o[2] = __builtin_amdgcn_mfma_f32_32x32x16_bf16(pa2, PK(f.l2, f.h2), o[2], 0, 0, 0); o[2] = __builtin_amdgcn_mfma_f32_32x32x16_bf16(pa3, PK(f.l3, f.h3), o[2], 0, 0, 0);
        vfrag_read<NCB, 3>(f, vb); asm volatile("s_waitcnt lgkmcnt(0)" ::: "memory"); __builtin_amdgcn_sched_barrier(0);
        o[3] = __builtin_amdgcn_mfma_f32_32x32x16_bf16(pa0, PK(f.l0, f.h0), o[3], 0, 0, 0); o[3] = __builtin_amdgcn_mfma_f32_32x32x16_bf16(pa1, PK(f.l1, f.h1), o[3], 0, 0, 0);
        o[3] = __builtin_amdgcn_mfma_f32_32x32x16_bf16(pa2, PK(f.l2, f.h2), o[3], 0, 0, 0); o[3] = __builtin_amdgcn_mfma_f32_32x32x16_bf16(pa3, PK(f.l3, f.h3), o[3], 0, 0, 0);
    }
#undef PK
}
template <int NQK, int KSTR> __device__ __forceinline__ void att_qkt(f32x16& p0, f32x16& p1, const char* kb, const bf16x8 (&qr)[NQK]) {
    p0 = f32x16{}; p1 = f32x16{};
#pragma unroll
    for (int s = 0; s < NQK; ++s) {
        const bf16x8 b0 = *(const bf16x8*)(kb + s * 32);
        const bf16x8 b1 = *(const bf16x8*)(kb + 32 * KSTR + s * 32);
        p0 = __builtin_amdgcn_mfma_f32_32x32x16_bf16(b0, qr[s], p0, 0, 0, 0);
        p1 = __builtin_amdgcn_mfma_f32_32x32x16_bf16(b1, qr[s], p1, 0, 0, 0);
    }
}
template <int NCB, int NVB> __device__ __forceinline__ void att_pv(f32x16 (&o)[NVB], int vb, bf16x8 pa0, bf16x8 pa1, bf16x8 pa2, bf16x8 pa3) {
    pv_one<NCB, 0>(o[0], vb, pa0, pa1, pa2, pa3);
    pv_one<NCB, 1>(o[1], vb, pa0, pa1, pa2, pa3);
    if constexpr (NVB == 4) { pv_one<NCB, 2>(o[2], vb, pa0, pa1, pa2, pa3); pv_one<NCB, 3>(o[3], vb, pa0, pa1, pa2, pa3); }
}

template <int NCB, int NVB> __device__ __forceinline__ void att_pv_sm(f32x16 (&o)[NVB], int vb, bf16x8 pa0, bf16x8 pa1, bf16x8 pa2, bf16x8 pa3,
                                                                        f32x16& p0, f32x16& p1, float& m_reg, float& alpha) {
#define SB() __builtin_amdgcn_sched_barrier(0)
#define LW() do { asm volatile("s_waitcnt lgkmcnt(0)" ::: "memory"); SB(); } while (0)
#define PK(L, H) (bf16x8){L[0], L[1], L[2], L[3], H[0], H[1], H[2], H[3]}
#define MX8(q) fmaxf(fmaxf(fmaxf(p0[4 * (q)], p0[4 * (q) + 1]), fmaxf(p0[4 * (q) + 2], p0[4 * (q) + 3])), fmaxf(fmaxf(p1[4 * (q)], p1[4 * (q) + 1]), fmaxf(p1[4 * (q) + 2], p1[4 * (q) + 3])))
#define EX4(P, b) do { P[(b)] = __builtin_amdgcn_exp2f(P[(b)] - mn); P[(b) + 1] = __builtin_amdgcn_exp2f(P[(b) + 1] - mn); P[(b) + 2] = __builtin_amdgcn_exp2f(P[(b) + 2] - mn); P[(b) + 3] = __builtin_amdgcn_exp2f(P[(b) + 3] - mn); asm volatile("" : "+v"(P)); } while (0)
#define SU4(P, b) do { P[(b)] -= mn; P[(b) + 1] -= mn; P[(b) + 2] -= mn; P[(b) + 3] -= mn; asm volatile("" : "+v"(P)); } while (0)
    float mn;
    VFrag fa, fb;
    vfrag_read<NCB, 0>(fa, vb);
    LW(); vfrag_read<NCB, 1>(fb, vb); SB();
    {
        o[0] = __builtin_amdgcn_mfma_f32_32x32x16_bf16(pa0, PK(fa.l0, fa.h0), o[0], 0, 0, 0); SB();
        float m0 = MX8(0); asm volatile("" : "+v"(m0)); SB();
        o[0] = __builtin_amdgcn_mfma_f32_32x32x16_bf16(pa1, PK(fa.l1, fa.h1), o[0], 0, 0, 0); SB();
        float m1 = MX8(1); asm volatile("" : "+v"(m1)); SB();
        o[0] = __builtin_amdgcn_mfma_f32_32x32x16_bf16(pa2, PK(fa.l2, fa.h2), o[0], 0, 0, 0); SB();
        float m2 = MX8(2); asm volatile("" : "+v"(m2)); SB();
        o[0] = __builtin_amdgcn_mfma_f32_32x32x16_bf16(pa3, PK(fa.l3, fa.h3), o[0], 0, 0, 0); SB();
        float m3 = MX8(3);
        float pmax = fmaxf(fmaxf(m0, m1), fmaxf(m2, m3));
        { auto rr = __builtin_amdgcn_permlane32_swap(__float_as_uint(pmax), __float_as_uint(pmax), false, false); pmax = fmaxf(__uint_as_float(rr[0]), __uint_as_float(rr[1])); }
        mn = (pmax - m_reg > ATT_THR) ? pmax : m_reg;
        alpha = __builtin_amdgcn_exp2f(m_reg - mn);
        m_reg = mn; asm volatile("" : "+v"(mn), "+v"(alpha)); SB();
    }
    LW(); if constexpr (NVB == 4) vfrag_read<NCB, 2>(fa, vb); SB();
    {
        o[1] = __builtin_amdgcn_mfma_f32_32x32x16_bf16(pa0, PK(fb.l0, fb.h0), o[1], 0, 0, 0); SB();
        EX4(p0, 0); SB();
        o[1] = __builtin_amdgcn_mfma_f32_32x32x16_bf16(pa1, PK(fb.l1, fb.h1), o[1], 0, 0, 0); SB();
        EX4(p0, 4); SB();
        o[1] = __builtin_amdgcn_mfma_f32_32x32x16_bf16(pa2, PK(fb.l2, fb.h2), o[1], 0, 0, 0); SB();
        EX4(p0, 8); SB();
        o[1] = __builtin_amdgcn_mfma_f32_32x32x16_bf16(pa3, PK(fb.l3, fb.h3), o[1], 0, 0, 0); SB();
        EX4(p0, 12); SB();
        if constexpr (NVB == 2) { SU4(p1, 0); SU4(p1, 4); SU4(p1, 8); SU4(p1, 12); SB(); }
    }
    if constexpr (NVB == 4) {
        LW(); vfrag_read<NCB, 3>(fb, vb); SB();
        {
            o[2] = __builtin_amdgcn_mfma_f32_32x32x16_bf16(pa0, PK(fa.l0, fa.h0), o[2], 0, 0, 0); SB();
            SU4(p1, 0); SU4(p1, 4); SB();
            o[2] = __builtin_amdgcn_mfma_f32_32x32x16_bf16(pa1, PK(fa.l1, fa.h1), o[2], 0, 0, 0); SB();
            SU4(p1, 8); SU4(p1, 12); SB();
            o[2] = __builtin_amdgcn_mfma_f32_32x32x16_bf16(pa2, PK(fa.l2, fa.h2), o[2], 0, 0, 0); SB();
            o[2] = __builtin_amdgcn_mfma_f32_32x32x16_bf16(pa3, PK(fa.l3, fa.h3), o[2], 0, 0, 0); SB();
        }
        LW();
        {
            o[3] = __builtin_amdgcn_mfma_f32_32x32x16_bf16(pa0, PK(fb.l0, fb.h0), o[3], 0, 0, 0);
            o[3] = __builtin_amdgcn_mfma_f32_32x32x16_bf16(pa1, PK(fb.l1, fb.h1), o[3], 0, 0, 0);
            o[3] = __builtin_amdgcn_mfma_f32_32x32x16_bf16(pa2, PK(fb.l2, fb.h2), o[3], 0, 0, 0);
            o[3] = __builtin_amdgcn_mfma_f32_32x32x16_bf16(pa3, PK(fb.l3, fb.h3), o[3], 0, 0, 0); SB();
        }
    }
#undef SB
#undef LW
#undef PK
#undef MX8
#undef EX4
#undef SU4
}

template <int NCB, int NVB> __device__ __forceinline__ void att_pv_sm_rel(f32x16 (&o)[NVB], int vb, bf16x8 pa0, bf16x8 pa1, bf16x8 pa2, bf16x8 pa3,
                                                                        f32x16& p0, f32x16& p1, float& m_reg, float& alpha, f32x16& negm) {
#define SB() __builtin_amdgcn_sched_barrier(0)
#define LW() do { asm volatile("s_waitcnt lgkmcnt(0)" ::: "memory"); SB(); } while (0)
#define PK(L, H) (bf16x8){L[0], L[1], L[2], L[3], H[0], H[1], H[2], H[3]}
#define MX8(q) 0
#define EX4(P, b) do { P[(b)] = __builtin_amdgcn_exp2f(P[(b)]); P[(b) + 1] = __builtin_amdgcn_exp2f(P[(b) + 1]); P[(b) + 2] = __builtin_amdgcn_exp2f(P[(b) + 2]); P[(b) + 3] = __builtin_amdgcn_exp2f(P[(b) + 3]); asm volatile("" : "+v"(P)); } while (0)
#define SU4(P, b) do { } while (0)
    float mn;
    VFrag fa, fb;
    vfrag_read<NCB, 0>(fa, vb);
    LW(); vfrag_read<NCB, 1>(fb, vb); SB();
    {
        o[0] = __builtin_amdgcn_mfma_f32_32x32x16_bf16(pa0, PK(fa.l0, fa.h0), o[0], 0, 0, 0); SB();
        float mx;
        asm("v_max3_f32 %0, %1, %2, %3\n\tv_max3_f32 %0, %0, %4, %5\n\tv_max3_f32 %0, %0, %6, %7\n\tv_max3_f32 %0, %0, %8, %9"
            : "=&v"(mx) : "v"(p0[0]), "v"(p0[1]), "v"(p0[2]), "v"(p0[3]), "v"(p1[0]), "v"(p1[1]), "v"(p1[2]), "v"(p1[3]), "v"(p0[4])); SB();
        o[0] = __builtin_amdgcn_mfma_f32_32x32x16_bf16(pa1, PK(fa.l1, fa.h1), o[0], 0, 0, 0); SB();
        asm("v_max3_f32 %0, %0, %1, %2\n\tv_max3_f32 %0, %0, %3, %4\n\tv_max3_f32 %0, %0, %5, %6\n\tv_max3_f32 %0, %0, %7, %8"
            : "+v"(mx) : "v"(p0[5]), "v"(p0[6]), "v"(p0[7]), "v"(p1[4]), "v"(p1[5]), "v"(p1[6]), "v"(p1[7]), "v"(p0[8])); SB();
        o[0] = __builtin_amdgcn_mfma_f32_32x32x16_bf16(pa2, PK(fa.l2, fa.h2), o[0], 0, 0, 0); SB();
        asm("v_max3_f32 %0, %0, %1, %2\n\tv_max3_f32 %0, %0, %3, %4\n\tv_max3_f32 %0, %0, %5, %6\n\tv_max3_f32 %0, %0, %7, %8"
            : "+v"(mx) : "v"(p0[9]), "v"(p0[10]), "v"(p0[11]), "v"(p1[8]), "v"(p1[9]), "v"(p1[10]), "v"(p1[11]), "v"(p0[12])); SB();
        o[0] = __builtin_amdgcn_mfma_f32_32x32x16_bf16(pa3, PK(fa.l3, fa.h3), o[0], 0, 0, 0); SB();
        asm("v_max3_f32 %0, %0, %1, %2\n\tv_max3_f32 %0, %0, %3, %4\n\tv_max3_f32 %0, %0, %5, %6"
            : "+v"(mx) : "v"(p0[13]), "v"(p0[14]), "v"(p0[15]), "v"(p1[12]), "v"(p1[13]), "v"(p1[14]));
        float pmax = fmaxf(mx, p1[15]);
        { auto rr = __builtin_amdgcn_permlane32_swap(__float_as_uint(pmax), __float_as_uint(pmax), false, false); pmax = fmaxf(__uint_as_float(rr[0]), __uint_as_float(rr[1])); }
        const float delta = pmax > ATT_THR ? pmax : 0.f;
        alpha = __builtin_amdgcn_exp2f(-delta);
        if (__any(delta > 0.f)) {
#pragma unroll
            for (int r = 0; r < 16; ++r) { p0[r] -= delta; p1[r] -= delta; }
            m_reg += delta;
#pragma unroll
            for (int r = 0; r < 16; ++r) negm[r] = -m_reg;
        }
        mn = 0.f; asm volatile("" : "+v"(alpha)); SB();
    }
    LW(); if constexpr (NVB == 4) vfrag_read<NCB, 2>(fa, vb); SB();
    {
        o[1] = __builtin_amdgcn_mfma_f32_32x32x16_bf16(pa0, PK(fb.l0, fb.h0), o[1], 0, 0, 0); SB();
        EX4(p0, 0); SB();
        o[1] = __builtin_amdgcn_mfma_f32_32x32x16_bf16(pa1, PK(fb.l1, fb.h1), o[1], 0, 0, 0); SB();
        EX4(p0, 4); SB();
        o[1] = __builtin_amdgcn_mfma_f32_32x32x16_bf16(pa2, PK(fb.l2, fb.h2), o[1], 0, 0, 0); SB();
        EX4(p0, 8); SB();
        o[1] = __builtin_amdgcn_mfma_f32_32x32x16_bf16(pa3, PK(fb.l3, fb.h3), o[1], 0, 0, 0); SB();
        EX4(p0, 12); SB();
        if constexpr (NVB == 2) { SU4(p1, 0); SU4(p1, 4); SU4(p1, 8); SU4(p1, 12); SB(); }
    }
    if constexpr (NVB == 4) {
        LW(); vfrag_read<NCB, 3>(fb, vb); SB();
        {
            o[2] = __builtin_amdgcn_mfma_f32_32x32x16_bf16(pa0, PK(fa.l0, fa.h0), o[2], 0, 0, 0); SB();
            SU4(p1, 0); SU4(p1, 4); SB();
            o[2] = __builtin_amdgcn_mfma_f32_32x32x16_bf16(pa1, PK(fa.l1, fa.h1), o[2], 0, 0, 0); SB();
            SU4(p1, 8); SU4(p1, 12); SB();
            o[2] = __builtin_amdgcn_mfma_f32_32x32x16_bf16(pa2, PK(fa.l2, fa.h2), o[2], 0, 0, 0); SB();
            o[2] = __builtin_amdgcn_mfma_f32_32x32x16_bf16(pa3, PK(fa.l3, fa.h3), o[2], 0, 0, 0); SB();
        }
        LW();
        {
            o[3] = __builtin_amdgcn_mfma_f32_32x32x16_bf16(pa0, PK(fb.l0, fb.h0), o[3], 0, 0, 0);
            o[3] = __builtin_amdgcn_mfma_f32_32x32x16_bf16(pa1, PK(fb.l1, fb.h1), o[3], 0, 0, 0);
            o[3] = __builtin_amdgcn_mfma_f32_32x32x16_bf16(pa2, PK(fb.l2, fb.h2), o[3], 0, 0, 0);
            o[3] = __builtin_amdgcn_mfma_f32_32x32x16_bf16(pa3, PK(fb.l3, fb.h3), o[3], 0, 0, 0); SB();
        }
    }
#undef SB
#undef LW
#undef PK
#undef MX8
#undef EX4
#undef SU4
}

template <int MODE>
__device__ __forceinline__ void attn_unit_p(char* lds, int wave0, const AttnIO io) {
    using C = ACfg<MODE>;
    static_assert(MODE == 0 || MODE == 1, "pipelined body: MLA and differential attention");
    constexpr int KW = C::KW, NQK = C::NQK, VW = C::VW, NVB = C::NVB, NRG = C::NRG, NT = C::NT;
    constexpr int KSTR = KW * 2 + 16, KBUF = 64 * KSTR, NCB = VW / 32, VBUF = 64 * VW * 2;
    constexpr int KCPR = KW / 8, KCH = 64 * KCPR, KPASS = (KCH + 511) / 512, VCPR = VW / 8, VCH = 64 * VCPR, VPASS = VCH / 512;
    constexpr int OFF_V = 2 * KBUF, OFF_WS = 2 * KBUF + 2 * VBUF;
    static_assert(NT % 2 == 0 && NT >= 4, "even tile count");
    int tid_ = wave0 * 64 + lane_id(); asm volatile("" : "+v"(tid_));
    const int tid = tid_, lane = tid & 63, r32 = lane & 31, hi = lane >> 5;
    const int wid = __builtin_amdgcn_readfirstlane(tid >> 6);
    const int rg = wid % NRG, part = wid / NRG;
    char* K_lds = lds; char* V_lds = lds + OFF_V;
    float* wsf = (float*)(lds + OFF_WS) + wid * 64;
    const int qk0 = (MODE == 1) ? 4 * part : 0;
    bf16x8 qr[NQK];
    {
        const bf16_t* Qw = io.Q + (size_t)(rg * 32 + r32) * io.ldq + ((MODE == 1) ? 64 * part : 0) + hi * 8;
#pragma unroll
        for (int s = 0; s < NQK; ++s) qr[s] = *(const bf16x8*)(Qw + s * 16);
    }
    f32x16 o[NVB];
#pragma unroll
    for (int d = 0; d < NVB; ++d) o[d] = f32x16{};
    float m_reg = -1e30f, l_reg = 0.f;
    struct { bf16x8 k[KPASS]; bf16x8 v[VPASS]; } sr_[2];
    constexpr int SE = 0, SO = 1;
#define P_SLOAD(S, t) do { const int k0_ = (t) * 64; \
        _Pragma("unroll") for (int i_ = 0; i_ < KPASS; ++i_) { const int id_ = tid + 512 * i_; if (KCH % 512 == 0 || id_ < KCH) sr_[S].k[i_] = *(const bf16x8*)(io.K + (size_t)(k0_ + id_ / KCPR) * io.ldk + (id_ % KCPR) * 8); } \
        _Pragma("unroll") for (int i_ = 0; i_ < VPASS; ++i_) { const int id_ = tid + 512 * i_; sr_[S].v[i_] = *(const bf16x8*)(io.V + (size_t)(k0_ + id_ / VCPR) * io.ldv + (id_ % VCPR) * 8); } } while (0)
#define P_SWRITE(b, S) do { \
        _Pragma("unroll") for (int i_ = 0; i_ < KPASS; ++i_) { const int id_ = tid + 512 * i_; if (KCH % 512 == 0 || id_ < KCH) *(bf16x8*)(K_lds + (b) * KBUF + (id_ / KCPR) * KSTR + (id_ % KCPR) * 16) = sr_[S].k[i_]; } \
        _Pragma("unroll") for (int i_ = 0; i_ < VPASS; ++i_) { const int id_ = tid + 512 * i_; *(bf16x8*)(V_lds + (b) * VBUF + v_st<NCB>(id_ / VCPR, (id_ % VCPR) * 8)) = sr_[S].v[i_]; } } while (0)
#define P_SWAIT() asm volatile("s_waitcnt vmcnt(%0)" :: "n"(VPASS + KCH / 512) : "memory")
#define P_RESC(a) do { if (__any((a) < 1.f)) { if (hi == 0) wsf[r32] = (a); asm volatile("s_waitcnt lgkmcnt(0)" ::: "memory"); \
        _Pragma("unroll") for (int r = 0; r < 16; ++r) { const float a_ = wsf[crow(r, hi)]; _Pragma("unroll") for (int d = 0; d < NVB; ++d) o[d][r] *= a_; } } } while (0)
#define P_SBAR() __builtin_amdgcn_sched_barrier(0)
    const char* kb0 = K_lds + r32 * KSTR + (qk0 * 16 + hi * 8) * 2;
    const int vbase = (int)(uintptr_t)V_lds + v_rd_base(lane);
    f32x16 pA0, pA1, pB0, pB1; float alA, alB; bf16x8 pa0, pa1, pa2, pa3;
    P_SLOAD(SE, 0); asm volatile("s_waitcnt vmcnt(0)" ::: "memory"); P_SWRITE(0, SE); __syncthreads();
    att_qkt<NQK, KSTR>(pA0, pA1, kb0, qr); att_partialSM(pA0, pA1, m_reg, alA);
    P_SLOAD(SO, 1); P_SLOAD(SE, 2);
    P_SWAIT(); P_SWRITE(1, SO); __syncthreads();
    for (int j = 1; j + 1 < NT; j += 2) {
        P_SBAR(); att_qkt<NQK, KSTR>(pB0, pB1, kb0 + KBUF, qr);
        att_finishSM(pA0, pA1, alA, l_reg, pa0, pa1, pa2, pa3); P_SBAR();
        P_SLOAD(SO, j + 2); P_SBAR();
        att_pv_sm<NCB, NVB>(o, vbase, pa0, pa1, pa2, pa3, pB0, pB1, m_reg, alB);
        __syncthreads(); P_SWAIT(); P_SWRITE(0, SE);
        P_RESC(alB); __syncthreads();
        P_SBAR(); att_qkt<NQK, KSTR>(pA0, pA1, kb0, qr);
        att_finishSM(pB0, pB1, alB, l_reg, pa0, pa1, pa2, pa3); P_SBAR();
        if (j + 3 < NT) P_SLOAD(SE, j + 3); P_SBAR();
        att_pv_sm<NCB, NVB>(o, vbase + VBUF, pa0, pa1, pa2, pa3, pA0, pA1, m_reg, alA);
        __syncthreads(); P_SWAIT(); P_SWRITE(1, SO);
        P_RESC(alA); __syncthreads();
    }
    P_SBAR(); att_qkt<NQK, KSTR>(pB0, pB1, kb0 + KBUF, qr);
    att_finishSM(pA0, pA1, alA, l_reg, pa0, pa1, pa2, pa3); P_SBAR();
    att_pv_sm<NCB, NVB>(o, vbase, pa0, pa1, pa2, pa3, pB0, pB1, m_reg, alB);
    __syncthreads(); P_RESC(alB);
    att_finishSM(pB0, pB1, alB, l_reg, pa0, pa1, pa2, pa3); P_SBAR();
    att_pv<NCB, NVB>(o, vbase + VBUF, pa0, pa1, pa2, pa3);
#undef P_SLOAD
#undef P_SWRITE
#undef P_SWAIT
#undef P_RESC
#undef P_SBAR
    __syncthreads();
    if (hi == 0) wsf[32 + r32] = l_reg;
    asm volatile("s_waitcnt lgkmcnt(0)" ::: "memory");
    float rli[16];
#pragma unroll
    for (int r = 0; r < 16; ++r) rli[r] = 1.0f / wsf[32 + crow(r, hi)];
    if constexpr (MODE == 1) {
        constexpr int XS = 132;
        float* X = (float*)lds;
        if (part == 1) {
#pragma unroll
            for (int r = 0; r < 16; ++r) { const int row = rg * 32 + crow(r, hi);
#pragma unroll
                for (int d = 0; d < NVB; ++d) X[row * XS + d * 32 + r32] = o[d][r] * rli[r]; }
        }
        __syncthreads();
        if (part == 0) {
#pragma unroll
            for (int r = 0; r < 16; ++r) { const int row = rg * 32 + crow(r, hi);
                float ss = 0.f;
#pragma unroll
                for (int d = 0; d < NVB; ++d) { const float t = o[d][r] * rli[r] - io.lam * X[row * XS + d * 32 + r32]; o[d][r] = t; ss += t * t; }
                ss += shx(ss, 1); ss += shx(ss, 2); ss += shx(ss, 4); ss += shx(ss, 8); ss += shx(ss, 16);
                const float rn = __builtin_amdgcn_rsqf(ss * (1.0f / 128) + SUBLN_EPS);
#pragma unroll
                for (int d = 0; d < NVB; ++d) io.O[(size_t)row * io.ldo + d * 32 + r32] = (bf16_t)f2bf(o[d][r] * rn);
            }
        }
        __syncthreads();
    } else {
#pragma unroll
        for (int r = 0; r < 16; ++r) { const int row = rg * 32 + crow(r, hi);
#pragma unroll
            for (int d = 0; d < NVB; ++d) io.O[(size_t)row * io.ldo + d * 32 + r32] = (bf16_t)f2bf(o[d][r] * rli[r]); }
    }
}

__device__ __forceinline__ void glds16(const void* gsrc, unsigned lds_dst) {
    unsigned keep;
    asm volatile("s_mov_b32 %0, m0\n\ts_mov_b32 m0, %2\n\ts_nop 0\n\tglobal_load_lds_dwordx4 %1, off\n\ts_mov_b32 m0, %0" : "=&s"(keep) : "v"(gsrc), "s"(lds_dst) : "memory");
}
template <int CPR> __device__ __forceinline__ int kswz(int r) { return CPR == 16 ? (r & 15) : (r & 3); }
template <int NQK, int CPR> __device__ __forceinline__ void att_qkt_d(f32x16& p0, f32x16& p1, const char* kslot, int r32, int hi, int qk0, const bf16x8 (&qr)[NQK], const f32x16& cin) {
    p0 = cin; p1 = cin;
    const char* r0 = kslot + r32 * (CPR * 16); const char* r1 = kslot + (32 + r32) * (CPR * 16);
    const int f0 = kswz<CPR>(r32), f1 = kswz<CPR>(32 + r32);
#pragma unroll
    for (int s = 0; s < NQK; ++s) {
        const int c = 2 * (qk0 + s) + hi;
        const bf16x8 b0 = *(const bf16x8*)(r0 + ((c ^ f0) << 4));
        const bf16x8 b1 = *(const bf16x8*)(r1 + ((c ^ f1) << 4));
        p0 = __builtin_amdgcn_mfma_f32_32x32x16_bf16(b0, qr[s], p0, 0, 0, 0);
        p1 = __builtin_amdgcn_mfma_f32_32x32x16_bf16(b1, qr[s], p1, 0, 0, 0);
    }
}
template <int MODE>
__device__ __forceinline__ void attn_unit_d(char* lds, int wave0, const AttnIO io) {
    using C = ACfg<MODE>;
    static_assert(MODE == 0 || MODE == 1, "LDS-DMA body: MLA and differential attention");
    constexpr int KW = C::KW, NQK = C::NQK, VW = C::VW, NVB = C::NVB, NRG = C::NRG, NT = C::NT;
    constexpr int CPR = KW / 8, KT = 64 * KW * 2, NCB = VW / 32, VT = 64 * VW * 2;
    constexpr int KI = KT / 1024, VI = VT / 1024;
    constexpr int KPW = (KI + 7) / 8, VPW = VI / 8;
    constexpr int OFF_V = 3 * KT, OFF_WS = 3 * KT + 3 * VT;
    static_assert(NT % 2 == 0 && NT >= 4 && OFF_WS + NWAVES * 256 <= LDS_BYTES - 64, "ring geometry");
    int tid_ = wave0 * 64 + lane_id(); asm volatile("" : "+v"(tid_));
    const int tid = tid_, lane = tid & 63, r32 = lane & 31, hi = lane >> 5;
    const int wid = __builtin_amdgcn_readfirstlane(tid >> 6);
    const int rg = wid % NRG, part = wid / NRG;
    float* wsf = (float*)(lds + OFF_WS) + wid * 64;
    const int qk0 = (MODE == 1) ? 4 * part : 0;
    const unsigned lds0 = (unsigned)(uintptr_t)lds;
    int ksrc[KPW], vsrc[VPW];
#pragma unroll
    for (int i = 0; i < KPW; ++i) { const int g = 64 * (wid + 8 * i) + lane, r = g / CPR, p = g % CPR; ksrc[i] = r * io.ldk + ((p ^ kswz<CPR>(r)) << 3); }
#pragma unroll
    for (int i = 0; i < VPW; ++i) { const int q = wid + 8 * i, st = 2 * q + (lane >> 5), kk = (st / NCB) * 8 + ((lane & 31) >> 2), k = (kk & ~0xC) | ((kk & 4) << 1) | ((kk & 8) >> 1);
        vsrc[i] = k * io.ldv + (st % NCB) * 32 + 8 * (lane & 3); }
    const bool k2 = (wid + 8 * (KPW - 1)) < KI;
#define D_DMA_K(t) do { const bf16_t* kt_ = io.K + (size_t)(t) * 64 * io.ldk; const unsigned sl_ = lds0 + ((t) % 3) * KT; \
        _Pragma("unroll") for (int i_ = 0; i_ < KPW; ++i_) if (i_ < KPW - 1 || k2) glds16(kt_ + ksrc[i_], (unsigned)__builtin_amdgcn_readfirstlane(sl_ + (wid + 8 * i_) * 1024)); } while (0)
#define D_DMA_V(t) do { const bf16_t* vt_ = io.V + (size_t)(t) * 64 * io.ldv; const unsigned sl_ = lds0 + OFF_V + ((t) % 3) * VT; \
        _Pragma("unroll") for (int i_ = 0; i_ < VPW; ++i_) glds16(vt_ + vsrc[i_], (unsigned)__builtin_amdgcn_readfirstlane(sl_ + (wid + 8 * i_) * 1024)); } while (0)
#define D_CLOSE_FLY() do { if (KPW == 2 && VPW == 2) asm volatile("s_waitcnt vmcnt(4) lgkmcnt(0)\n\ts_barrier" ::: "memory"); \
        else if (k2) asm volatile("s_waitcnt vmcnt(3) lgkmcnt(0)\n\ts_barrier" ::: "memory"); else asm volatile("s_waitcnt vmcnt(2) lgkmcnt(0)\n\ts_barrier" ::: "memory"); } while (0)
#define D_CLOSE_ALL() asm volatile("s_waitcnt vmcnt(0) lgkmcnt(0)\n\ts_barrier" ::: "memory")
#define D_RESC(a) do { if (__any((a) < 1.f)) { if (hi == 0) wsf[r32] = (a); asm volatile("s_waitcnt lgkmcnt(0)" ::: "memory"); \
        _Pragma("unroll") for (int r = 0; r < 16; ++r) { const float a_ = wsf[crow(r, hi)]; _Pragma("unroll") for (int d = 0; d < NVB; ++d) o[d][r] *= a_; } } } while (0)
#define D_SBAR() __builtin_amdgcn_sched_barrier(0)
    D_DMA_K(0); D_DMA_V(0); D_DMA_K(1);
    bf16x8 qr[NQK];
    {
        const bf16_t* Qw = io.Q + (size_t)(rg * 32 + r32) * io.ldq + ((MODE == 1) ? 64 * part : 0) + hi * 8;
#pragma unroll
        for (int s = 0; s < NQK; ++s) qr[s] = *(const bf16x8*)(Qw + s * 16);
    }
    f32x16 o[NVB];
#pragma unroll
    for (int d = 0; d < NVB; ++d) o[d] = f32x16{};
    float m_reg = -1e30f, l_reg = 0.f;
    const int vbase = (int)lds0 + OFF_V + v_rd_base2<NCB>(lane);
    f32x16 pA0, pA1, pB0, pB1; float alA, alB; bf16x8 pa0, pa1, pa2, pa3;
    D_CLOSE_ALL();
    D_DMA_K(2); D_DMA_V(1);
    f32x16 negm = f32x16{};
    att_qkt_d<NQK, CPR>(pA0, pA1, lds, r32, hi, qk0, qr, negm); att_partialSM(pA0, pA1, m_reg, alA);
#pragma unroll
    for (int r = 0; r < 16; ++r) negm[r] = -m_reg;
    D_CLOSE_FLY();
    for (int s = 1; s + 1 < NT; s += 2) {
        if (s + 2 < NT) D_DMA_K(s + 2);
        D_DMA_V(s + 1);
        D_SBAR(); if (wid >= 4) __builtin_amdgcn_s_setprio(2); else __builtin_amdgcn_s_setprio(1); att_qkt_d<NQK, CPR>(pB0, pB1, lds + (s % 3) * KT, r32, hi, qk0, qr, negm);
        att_finishSM2(pA0, pA1, alA, l_reg, pa0, pa1, pa2, pa3); D_SBAR();
        att_pv_sm_rel<NCB, NVB>(o, vbase + ((s - 1) % 3) * VT, pa0, pa1, pa2, pa3, pB0, pB1, m_reg, alB, negm);
        __builtin_amdgcn_s_setprio(0); D_RESC(alB);
        if (s + 2 < NT) D_CLOSE_FLY(); else D_CLOSE_ALL();
        if (s + 3 < NT) D_DMA_K(s + 3);
        if (s + 2 < NT) D_DMA_V(s + 2);
        D_SBAR(); if (wid >= 4) __builtin_amdgcn_s_setprio(2); else __builtin_amdgcn_s_setprio(1); att_qkt_d<NQK, CPR>(pA0, pA1, lds + ((s + 1) % 3) * KT, r32, hi, qk0, qr, negm);
        att_finishSM2(pB0, pB1, alB, l_reg, pa0, pa1, pa2, pa3); D_SBAR();
        att_pv_sm_rel<NCB, NVB>(o, vbase + (s % 3) * VT, pa0, pa1, pa2, pa3, pA0, pA1, m_reg, alA, negm);
        __builtin_amdgcn_s_setprio(0); D_RESC(alA);
        if (s + 3 < NT) D_CLOSE_FLY(); else D_CLOSE_ALL();
    }
    D_SBAR(); att_qkt_d<NQK, CPR>(pB0, pB1, lds + ((NT - 1) % 3) * KT, r32, hi, qk0, qr, negm);
    att_finishSM2(pA0, pA1, alA, l_reg, pa0, pa1, pa2, pa3); D_SBAR();
    att_pv_sm_rel<NCB, NVB>(o, vbase + ((NT - 2) % 3) * VT, pa0, pa1, pa2, pa3, pB0, pB1, m_reg, alB, negm);
    D_RESC(alB);
    att_finishSM2(pB0, pB1, alB, l_reg, pa0, pa1, pa2, pa3); D_SBAR();
    att_pv2<NCB, NVB>(o, vbase + ((NT - 1) % 3) * VT, pa0, pa1, pa2, pa3);
#undef D_DMA_K
#undef D_DMA_V
#undef D_CLOSE_FLY
#undef D_CLOSE_ALL
#undef D_RESC
#undef D_SBAR
    asm volatile("s_waitcnt vmcnt(0) lgkmcnt(0)\n\ts_barrier" ::: "memory");
    if (hi == 0) wsf[32 + r32] = l_reg;
    asm volatile("s_waitcnt lgkmcnt(0)" ::: "memory");
    float rli[16];
#pragma unroll
    for (int r = 0; r < 16; ++r) rli[r] = __builtin_amdgcn_rcpf(wsf[32 + crow(r, hi)]);
    if constexpr (MODE == 1) {
        constexpr int XS = 132;
        float* X = (float*)lds;
        if (part == 1) {
#pragma unroll
            for (int r = 0; r < 16; ++r) { const int row = rg * 32 + crow(r, hi);
#pragma unroll
                for (int d = 0; d < NVB; ++d) X[row * XS + d * 32 + r32] = o[d][r] * rli[r]; }
        }
        __syncthreads();
        if (part == 0) {
#pragma unroll
            for (int r = 0; r < 16; ++r) { const int row = rg * 32 + crow(r, hi);
#pragma unroll
                for (int d = 0; d < NVB; ++d) { float* xp = X + row * XS + d * 32 + r32; *xp = o[d][r] * rli[r] - io.lam * *xp; } }
            asm volatile("s_waitcnt lgkmcnt(0)" ::: "memory");
#pragma unroll
            for (int i = 0; i < 8; ++i) { const int rw = rg * 32 + i * 4 + (lane >> 4), ch = lane & 15;
                const f32x4 a = *(const f32x4*)(X + rw * XS + ch * 8), b = *(const f32x4*)(X + rw * XS + ch * 8 + 4);
                float ss = ((a.x * a.x + a.y * a.y) + (a.z * a.z + a.w * a.w)) + ((b.x * b.x + b.y * b.y) + (b.z * b.z + b.w * b.w));
                ss += __builtin_bit_cast(float, __builtin_amdgcn_update_dpp(0, __builtin_bit_cast(int, ss), 0xB1, 0xf, 0xf, false));
                ss += __builtin_bit_cast(float, __builtin_amdgcn_update_dpp(0, __builtin_bit_cast(int, ss), 0x4E, 0xf, 0xf, false));
                ss += __builtin_bit_cast(float, __builtin_amdgcn_update_dpp(0, __builtin_bit_cast(int, ss), 0x124, 0xf, 0xf, false));
                ss += __builtin_bit_cast(float, __builtin_amdgcn_update_dpp(0, __builtin_bit_cast(int, ss), 0x128, 0xf, 0xf, false));
                const float rn = __builtin_amdgcn_rsqf(ss * (1.0f / 128) + SUBLN_EPS);
                float v[8] = {a.x * rn, a.y * rn, a.z * rn, a.w * rn, b.x * rn, b.y * rn, b.z * rn, b.w * rn};
                *(u32x4*)(io.O + (size_t)rw * io.ldo + ch * 8) = pack8(v); }
        }
        __syncthreads();
    } else {
        bf16_t* stg = (bf16_t*)lds + wid * (32 * 72);
#pragma unroll
        for (int r = 0; r < 16; ++r) { const int rw = crow(r, hi);
#pragma unroll
            for (int d = 0; d < NVB; ++d) stg[rw * 72 + d * 32 + r32] = (bf16_t)f2bf(o[d][r] * rli[r]); }
        asm volatile("s_waitcnt lgkmcnt(0)" ::: "memory");
#pragma unroll
        for (int i = 0; i < 4; ++i) { const int rw = i * 8 + (lane >> 3), ch = lane & 7;
            const u32x4 v = *(const u32x4*)(stg + rw * 72 + ch * 8);
            *(u32x4*)(io.O + (size_t)(rg * 32 + rw) * io.ldo + ch * 8) = v; }
        asm volatile("s_waitcnt lgkmcnt(0)\n\ts_barrier" ::: "memory");
    }
}

constexpr int HY_ZSE = 2048 + 16;
constexpr int HY_ZBYTES = 16 * HY_ZSE * 2;
constexpr int HY_CSB = 8192 + 64;
__device__ __forceinline__ void hyena_unit(char* lds, int wave0, int c, const bf16_t* HYT, const bf16_t* FILT, const float* conv_w, const float* conv_b, const float* skip, bf16_t* MIX) {
    int tid_ = wave0 * 64 + lane_id(); asm volatile("" : "+v"(tid_));
    const int tid = tid_, lane = tid & 63, i = lane & 15, g = lane >> 4;
    const int wid = __builtin_amdgcn_readfirstlane(tid >> 6), q = wid >> 1, rho = wid & 1;
    bf16_t* Z = (bf16_t*)lds; char* F = lds + HY_ZBYTES;
    {
        const float w0 = conv_w[c], w1 = conv_w[1536 + c], w2 = conv_w[3072 + c], bb = conv_b[c];
        const bf16_t* src = HYT + (size_t)c * T_TOK;
#pragma unroll 2
        for (int k = 0; k < 8; ++k) {
            const int id = tid + 512 * k, b = id >> 8, s0 = (id & 255) * 8;
            const bf16x8 x = *(const bf16x8*)(src + b * SEQ + s0);
            const float pvr = bf2f(src[b * SEQ + s0 + (s0 > 0 ? -1 : 0)]), nxr = bf2f(src[b * SEQ + s0 + (s0 + 8 < SEQ ? 8 : 7)]);
            const float pv = s0 > 0 ? pvr : 0.f, nx = s0 + 8 < SEQ ? nxr : 0.f;
            float e[10]; e[0] = pv; e[9] = nx;
#pragma unroll
            for (int j = 0; j < 8; ++j) e[j + 1] = bf2f((unsigned short)x[j]);
            float r[8];
#pragma unroll
            for (int j = 0; j < 8; ++j) r[j] = w0 * e[j] + w1 * e[j + 1] + w2 * e[j + 2] + bb;
            *(u32x4*)(Z + b * HY_ZSE + s0) = pack8(r);
        }
    }
    for (int ord = 0; ord < 2; ++ord) {
        {
            const bf16_t* R = FILT + (size_t)(ord * 512 + c) * 4096;
#pragma unroll
            for (int k = 0; k < 8; ++k) {
                const int idx = tid + 512 * k; const bf16_t val = R[idx];
#pragma unroll
                for (int m = 0; m < 4; ++m) if (idx >= m) *(bf16_t*)(F + m * HY_CSB + (idx - m) * 2) = val;
            }
        }
        __syncthreads();
        f32x4 acc[16];
#pragma unroll
        for (int a = 0; a < 16; ++a) acc[a] = (f32x4){0.f, 0.f, 0.f, 0.f};
        {
            const int m = (3 - i) & 3, n0 = 2047 - i - m + 8 * g;
            const char* Ab = F + m * HY_CSB + 2 * (n0 - (512 * q + 16 * rho));
            const char* Zb = (const char*)Z + i * (HY_ZSE * 2) + g * 16;
            bf16x8 W[16];
#define HY_LDA(u) ({ const u32x2 lo_ = *(const u32x2*)(Ab - 64 * (u)); const u32x2 hi_ = *(const u32x2*)(Ab - 64 * (u) + 8); u32x4 w_ = {lo_.x, lo_.y, hi_.x, hi_.y}; __builtin_bit_cast(bf16x8, w_); })
#pragma unroll
            for (int u = 0; u < 16; ++u) W[u] = HY_LDA(u);
            bf16x8 Bn = *(const bf16x8*)Zb;
            for (int sb = 0; sb < 64; sb += 16) {
#pragma unroll
                for (int s1 = 0; s1 < 16; ++s1) {
                    const int sg = sb + s1;
                    const bf16x8 B = Bn;
                    bf16x8 Wn = W[15 - s1];
                    if (sg < 63) { Bn = *(const bf16x8*)(Zb + 64 * (sg + 1)); Wn = HY_LDA(-(sg + 1)); }
                    __builtin_amdgcn_s_setprio(1);
#pragma unroll
                    for (int a = 0; a < 16; ++a) acc[a] = __builtin_amdgcn_mfma_f32_16x16x32_bf16(W[(a - s1) & 15], B, acc[a], 0, 0, 0);
                    __builtin_amdgcn_s_setprio(0);
                    W[15 - s1] = Wn;
                }
            }
#undef HY_LDA
        }
        __syncthreads();
        {
            const int gch = 512 * (ord + 1) + c;
            bf16_t* X = (bf16_t*)F;
            int tg = tid; asm volatile("" : "+v"(tg));
            {
                const bf16_t* gsrc = HYT + (size_t)gch * T_TOK;
                const bf16_t* gp = gsrc + (tg >> 8) * SEQ + (tg & 255) * 8; bf16_t* xp = X + (tg >> 8) * HY_ZSE + (tg & 255) * 8;
#pragma unroll
                for (int h = 0; h < 2; ++h) {
                    u32x4 xt[4];
#pragma unroll
                    for (int k = 0; k < 4; ++k) xt[k] = *(const u32x4*)(gp + (size_t)(4 * h + k) * 2 * SEQ);
#pragma unroll
                    for (int k = 0; k < 4; ++k) *(u32x4*)(xp + (4 * h + k) * 2 * HY_ZSE) = xt[k];
                }
            }
            __syncthreads();
            const float w0 = conv_w[gch], w1 = conv_w[1536 + gch], w2 = conv_w[3072 + gch], bb = conv_b[gch], sk = skip[ord * 512 + c];
            const int ig = tg & 15, gg = (tg & 63) >> 4;
            const int tb = 512 * q + 16 * rho + 4 * gg;
#pragma unroll
            for (int a = 0; a < 16; ++a) {
                const int t = tb + 32 * a;
                const bf16_t* xs = X + ig * HY_ZSE + t;
                const u32x2 xr = *(const u32x2*)xs;
                const unsigned short hp = (unsigned short)xs[t > 0 ? -1 : 0], hn = (unsigned short)xs[t + 4 < SEQ ? 4 : 3];
                const float pv = t > 0 ? bf2f(hp) : 0.f, nx = t + 4 < SEQ ? bf2f(hn) : 0.f;
                float e[6]; e[0] = pv; e[1] = bf2f((unsigned short)(xr.x & 0xffff)); e[2] = bf2f((unsigned short)(xr.x >> 16)); e[3] = bf2f((unsigned short)(xr.y & 0xffff)); e[4] = bf2f((unsigned short)(xr.y >> 16)); e[5] = nx;
                const u32x2 zo = *(const u32x2*)(Z + ig * HY_ZSE + t);
                float zf[4]; zf[0] = bf2f((unsigned short)(zo.x & 0xffff)); zf[1] = bf2f((unsigned short)(zo.x >> 16)); zf[2] = bf2f((unsigned short)(zo.y & 0xffff)); zf[3] = bf2f((unsigned short)(zo.y >> 16));
                float zn[4];
#pragma unroll
                for (int r = 0; r < 4; ++r) { const float gate = w0 * e[r] + w1 * e[r + 1] + w2 * e[r + 2] + bb; zn[r] = gate * (acc[a][r] + sk * zf[r]); }
                u32x2 w; w.x = cvt_pk_bf16(zn[0], zn[1]); w.y = cvt_pk_bf16(zn[2], zn[3]); *(u32x2*)(Z + ig * HY_ZSE + t) = w;
            }
            if (ord == 1) {
                __syncthreads();
                bf16_t* zt = MIX + (size_t)c * T_TOK;
                bf16_t* op = zt + (tg >> 8) * SEQ + (tg & 255) * 8; const bf16_t* zp = Z + (tg >> 8) * HY_ZSE + (tg & 255) * 8;
#pragma unroll
                for (int k = 0; k < 8; ++k) *(u32x4*)(op + (size_t)k * 2 * SEQ) = *(const u32x4*)(zp + k * 2 * HY_ZSE);
            }
        }
        __syncthreads();
    }
}

#define KARG_AS __attribute__((address_space(4)))
__device__ __forceinline__ unsigned char* arg_ws() { const char KARG_AS* ka = (const char KARG_AS*)__builtin_amdgcn_kernarg_segment_ptr(); return *(unsigned char* const volatile KARG_AS*)(ka + 8 * 35); }
__device__ __forceinline__ float* arg_out() { const char KARG_AS* ka = (const char KARG_AS*)__builtin_amdgcn_kernarg_segment_ptr(); return *(float* const volatile KARG_AS*)(ka + 8 * 34); }
__device__ __forceinline__ const float* arg_in(int k) {
    const char __attribute__((address_space(4)))* ka = (const char __attribute__((address_space(4)))*)__builtin_amdgcn_kernarg_segment_ptr();
    return *(const float* const volatile __attribute__((address_space(4)))*)(ka + 8 * k);
}
__device__ __forceinline__ int rowmap(int mode, int n) {
    if (mode == 1) { if (n < 1920) return n; const int i = n - 1920; return 1920 + (i < 16 ? 2 * i : 2 * (i - 16) + 1); }
    if (mode == 2) { const int h = n / 96, j = n % 96; if (j < 64) return n; const int i = j - 64; return h * 96 + 64 + (i < 16 ? 2 * i : 2 * (i - 16) + 1); }
    if (mode == 3) { if (n >= 2048) return n; const int j = n & 63; return (n & ~63) + (j < 32 ? 2 * j : 2 * (j - 32) + 1); }
    return n;
}
__device__ __forceinline__ void transpose_item(const float* W, int K, int N, bf16_t* WT, int ldt, int koff, int rowoff, int mode, const float* gain, int gmod, float gs, LAS float* scr, int item, int lane) {
    const int nblk = N / 32, kb = item / nblk, nb = item % nblk, k0 = 64 * kb, n0 = 32 * nb;
    scr[64 * 33 + lane] = gain ? gain[(k0 + lane) % gmod] * gs : gs;
    float t[32];
    const float* src = W + (size_t)(k0 + (lane >> 5)) * N + n0 + (lane & 31);
#pragma unroll
    for (int i = 0; i < 32; ++i) t[i] = src[(size_t)(2 * i) * N];
    asm volatile("s_waitcnt lgkmcnt(0)" ::: "memory");
#pragma unroll
    for (int i = 0; i < 32; ++i) { const int kk = 2 * i + (lane >> 5); scr[kk * 33 + (lane & 31)] = t[i] * scr[64 * 33 + kk]; }
    asm volatile("s_waitcnt lgkmcnt(0)" ::: "memory");
    const int c = lane & 7;
#pragma unroll
    for (int j = 0; j < 4; ++j) { const int n = (lane >> 3) + 8 * j; const LAS float* s = scr + (8 * c) * 33 + n;
        u32x4 o; o.x = cvt_pk_bf16(s[0 * 33], s[1 * 33]); o.y = cvt_pk_bf16(s[2 * 33], s[3 * 33]); o.z = cvt_pk_bf16(s[4 * 33], s[5 * 33]); o.w = cvt_pk_bf16(s[6 * 33], s[7 * 33]);
        *(u32x4*)(WT + (size_t)(rowoff + rowmap(mode, n0 + n)) * ldt + koff + k0 + 8 * c) = o; }
    asm volatile("s_waitcnt lgkmcnt(0)" ::: "memory");
}

__device__ __forceinline__ void phase_prologue(char* lds, int wave0) {
    const int lane = lane_id(), wave = wave0, tid = wave * 64 + lane;
    const int G = gridDim.x, gw = blockIdx.x * NWAVES + wave, NGW = G * NWAVES;
    const long gt = (long)blockIdx.x * NTHREADS + tid, NGT = (long)G * NTHREADS;
    unsigned char* ws = arg_ws();
    LAS float* scr = (LAS float*)((LAS unsigned char*)lds + wave * 16384);
#ifndef PRO_DUP
#define PRO_DUP 0
#endif
    for (int rp_ = 0; rp_ < ((PRO_DUP & 1) ? 2 : 1); ++rp_) {
        constexpr int I0 = 16 * 61, I1 = 4 * 24, I2 = 2 * 32, I3 = 16 * 32, I4 = 16 * 96, I5 = 16 * 32, IXQ = 16 * 32, IXKV = 16 * 64, IXO = 16 * 32, IUP = 16 * 128, IDN = 64 * 32;
        constexpr int NIT = I0 + I1 + I2 + I3 + I4 + I5 + 2 * (IXQ + IXKV + IXO + IUP + IDN);
        for (int it = gw; it < NIT; it += NGW) {
            int r = it;
            if (r < I0) { transpose_item(arg_in(2), 1024, 1952, (bf16_t*)(ws + WS_W_IN), 1024, 0, 0, 1, arg_in(24), 1024, 1.f, scr, r, lane); continue; } r -= I0;
            if (r < I1) { transpose_item(arg_in(13), 256, 768, (bf16_t*)(ws + WS_W_UQ), 256, 0, 0, 2, arg_in(12), 256, 1.f, scr, r, lane); continue; } r -= I1;
            if (r < I2) { transpose_item(arg_in(15), 128, 1024, (bf16_t*)(ws + WS_W_UKV), 256, 128, 0, 0, arg_in(14), 128, 1.f, scr, r, lane); continue; } r -= I2;
            if (r < I3) { transpose_item(arg_in(16), 1024, 1024, (bf16_t*)(ws + WS_W_OUT0), 1024, 0, 0, 0, nullptr, 1, 1.f, scr, r, lane); continue; } r -= I3;
            if (r < I4) { transpose_item(arg_in(17), 1024, 3072, (bf16_t*)(ws + WS_W_QKV), 1024, 0, 0, 3, arg_in(24) + 1024, 1024, 1.f, scr, r, lane); continue; } r -= I4;
            if (r < I5) { transpose_item(arg_in(23), 1024, 1024, (bf16_t*)(ws + WS_W_OUT1), 1024, 0, 0, 0, arg_in(22), 128, 1.0f - LAM_INIT, scr, r, lane); continue; } r -= I5;
            const int l = r / (IXQ + IXKV + IXO + IUP + IDN); r -= l * (IXQ + IXKV + IXO + IUP + IDN);
            if (r < IXQ) { transpose_item(arg_in(27) + (size_t)l * 1024 * 1024, 1024, 1024, (bf16_t*)(ws + WS_W_XQ) + (size_t)l * 1024 * 1024, 1024, 0, 0, 0, arg_in(25) + l * 1024, 1024, 1.f, scr, r, lane); continue; } r -= IXQ;
            if (r < IXKV) { transpose_item(arg_in(28) + (size_t)l * 1024 * 2048, 1024, 2048, (bf16_t*)(ws + WS_W_XKV), 1024, 0, l * 2048, 0, nullptr, 1, 1.f, scr, r, lane); continue; } r -= IXKV;
            if (r < IXO) { transpose_item(arg_in(29) + (size_t)l * 1024 * 1024, 1024, 1024, (bf16_t*)(ws + WS_W_XO) + (size_t)l * 1024 * 1024, 1024, 0, 0, 0, nullptr, 1, 1.f, scr, r, lane); continue; } r -= IXO;
            if (r < IUP) { transpose_item(arg_in(30) + (size_t)l * 1024 * 4096, 1024, 4096, (bf16_t*)(ws + WS_W_UP) + (size_t)l * 4096 * 1024, 1024, 0, 0, 0, arg_in(26) + l * 1024, 1024, 1.f, scr, r, lane); continue; } r -= IUP;
            transpose_item(arg_in(31) + (size_t)l * 4096 * 1024, 4096, 1024, (bf16_t*)(ws + WS_W_DN) + (size_t)l * 1024 * 4096, 4096, 0, 0, 0, nullptr, 1, 1.f, scr, r, lane);
        }
        for (long i = gt; i < 12288 + 16384; i += NGT) {
            if (i < 12288) *(u32x4*)(ws + WS_W_IN + (size_t)1952 * 2048 + i * 16) = (u32x4){0u, 0u, 0u, 0u};
            else { const long k = i - 12288; *(u32x4*)(ws + WS_W_UKV + (size_t)(k >> 4) * 512 + (k & 15) * 16) = (u32x4){0u, 0u, 0u, 0u}; }
        }
    }
    for (int rp_ = 0; rp_ < ((PRO_DUP & 2) ? 2 : 1); ++rp_)
    for (int row0 = gw; row0 < T_TOK + NB * NMEM; row0 += 2 * NGW) {
        f32x4 v[2][4];
#pragma unroll
        for (int u = 0; u < 2; ++u) { const int row = row0 + u * NGW; if (row < T_TOK + NB * NMEM) { const bool isx = row < T_TOK; const int r2 = isx ? row : row - T_TOK;
            const float* src = (isx ? arg_in(0) : arg_in(1)) + (size_t)r2 * DM;
#pragma unroll
            for (int j = 0; j < 4; ++j) v[u][j] = *(const f32x4*)(src + 4 * lane + 256 * j); } }
#pragma unroll
        for (int u = 0; u < 2; ++u) { const int row = row0 + u * NGW; if (row < T_TOK + NB * NMEM) { const bool isx = row < T_TOK; const int r2 = isx ? row : row - T_TOK;
            float s = 0.f;
#pragma unroll
            for (int j = 0; j < 4; ++j) s += (v[u][j].x * v[u][j].x + v[u][j].y * v[u][j].y) + (v[u][j].z * v[u][j].z + v[u][j].w * v[u][j].w);
            s = wave_sum(s);
            if (isx) {
                bf16_t* dst = (bf16_t*)(ws + WS_XB) + (size_t)r2 * DM;
#pragma unroll
                for (int j = 0; j < 4; ++j) { u32x2 w; w.x = cvt_pk_bf16(v[u][j].x, v[u][j].y); w.y = cvt_pk_bf16(v[u][j].z, v[u][j].w); *(u32x2*)(dst + 4 * lane + 256 * j) = w; }
                if (lane < 16) ((float*)(ws + WS_RSS))[rss_idx(r2, lane)] = lane == 0 ? s : 0.f;
            } else {
                const float rn = 1.0f / sqrtf(s * (1.0f / DM) + EPS);
                bf16_t* dst = (bf16_t*)(ws + WS_MEMN) + (size_t)r2 * DM;
#pragma unroll
                for (int j = 0; j < 4; ++j) { const f32x4 gg = *(const f32x4*)(arg_in(32) + 4 * lane + 256 * j);
                    u32x2 w; w.x = cvt_pk_bf16(v[u][j].x * rn * gg.x, v[u][j].y * rn * gg.y); w.y = cvt_pk_bf16(v[u][j].z * rn * gg.z, v[u][j].w * rn * gg.w); *(u32x2*)(dst + 4 * lane + 256 * j) = w; }
            } } }
    }
    {
        const float* w1 = arg_in(5); const float* b1 = arg_in(6); const float* w2 = arg_in(7); const float* b2 = arg_in(8); const float* w3 = arg_in(9); const float* fr = arg_in(10);
        bf16_t* FILT = (bf16_t*)(ws + WS_FILT);
        __syncthreads();
        float* sc = (float*)(lds + wave * 16384);
        float* a2s = (float*)(lds + 8 * 16384);
        for (int rp_ = 0; rp_ < ((PRO_DUP & 8) ? 2 : 1); ++rp_)
        for (int pb = blockIdx.x; pb < SEQ / 8; pb += G) {
            const int l = pb * 8 + wave;
            const float tl = (float)l / 2047.0f, wl = (6.283185307179586f / 2048.0f) * (float)l;
            if (lane < 33) {
                float fv;
                if (lane == 0) fv = tl;
                else { const int kb = (lane - 1) & 15; const float band = 1e-4f + (15.0f - 1e-4f) * ((float)kb / 15.0f); fv = lane <= 16 ? cosf(band * wl) : -sinf(band * wl); }
                sc[lane] = fv;
            }
            float wv[64];
            const float* w1p = w1 + lane; const float* w2p = w2 + lane;
            asm volatile("" : "+v"(w1p), "+v"(w2p));
#pragma unroll
            for (int k = 0; k < 33; ++k) wv[k] = w1p[k * 64];
            asm volatile("s_waitcnt lgkmcnt(0)" ::: "memory");
            float s1 = b1[lane];
#pragma unroll
            for (int k = 0; k < 33; ++k) s1 += sc[k] * wv[k];
            sc[64 + lane] = sinf(fr[lane] * s1);
#pragma unroll
            for (int k = 0; k < 64; ++k) wv[k] = w2p[k * 64];
            asm volatile("s_waitcnt lgkmcnt(0)" ::: "memory");
            float s2 = b2[lane];
#pragma unroll
            for (int k = 0; k < 64; ++k) s2 += sc[64 + k] * wv[k];
            a2s[lane * 8 + wave] = sinf(fr[lane] * s2);
            __syncthreads();
            f32x4 acc[8];
#pragma unroll
            for (int p = 0; p < 8; ++p) acc[p] = (f32x4){0.f, 0.f, 0.f, 0.f};
            const f32x4* rp = (const f32x4*)w3 + tid;
#pragma unroll 1
            for (int kq = 0; kq < 64; kq += 8) {
                asm volatile("" : "+v"(rp));
                f32x4 wq[8];
#pragma unroll
                for (int j = 0; j < 8; ++j) wq[j] = rp[j * 512];
#pragma unroll
                for (int j = 0; j < 8; ++j) {
                    const f32x4 w = wq[j];
                    const f32x4 aL = *(const f32x4*)(a2s + (kq + j) * 8), aH = *(const f32x4*)(a2s + (kq + j) * 8 + 4);
                    acc[0] += aL.x * w; acc[1] += aL.y * w; acc[2] += aL.z * w; acc[3] += aL.w * w;
                    acc[4] += aH.x * w; acc[5] += aH.y * w; acc[6] += aH.z * w; acc[7] += aH.w * w;
                }
                rp += 8 * 512;
            }
            const int col0 = 4 * tid, ord = col0 >> 10, dir = (col0 >> 9) & 1, c0 = col0 & 511;
#pragma unroll
            for (int e = 0; e < 4; ++e) {
                const int c = c0 + e;
                const float delta = -3.0701134573253944f + (-15.350567286626972f + 3.0701134573253944f) * ((float)c / 511.0f);
                float val[8];
#pragma unroll
                for (int p = 0; p < 8; ++p) val[p] = acc[p][e] * expf(-((float)(pb * 8 + p) / 2047.0f) * fabsf(delta));
                bf16_t* R = FILT + (size_t)(ord * 512 + c) * 4096;
                if (dir == 0) {
                    u32x4 wv4; wv4.x = cvt_pk_bf16(val[7], val[6]); wv4.y = cvt_pk_bf16(val[5], val[4]); wv4.z = cvt_pk_bf16(val[3], val[2]); wv4.w = cvt_pk_bf16(val[1], val[0]);
                    *(u32x4*)(R + 2040 - 8 * pb) = wv4;
                } else {
#pragma unroll
                    for (int p = 0; p < 8; ++p) { const int ll = pb * 8 + p; if (ll >= 1) R[2047 + ll] = (bf16_t)f2bf(val[p]); else R[4095] = 0; }
                }
            }
            __syncthreads();
        }
    }
}

#define XB_TMO      128
#define XB_XCNT(j)  (256  + 64 * (j))
#define XB_XSUB(j)  (1280 + 64 * (j))
#define XB_XGEN(j)  (2304 + 64 * (j))
#define XB_TOP      3328
#define XB_TOPGEN   3392
#define XCD_BAR_WORDS 3456
#define XB_SPIN_CAP (1u << 22)
__device__ __forceinline__ unsigned xb_ld(unsigned* p)              { return __hip_atomic_load(p, __ATOMIC_RELAXED, __HIP_MEMORY_SCOPE_AGENT); }
__device__ __forceinline__ unsigned xb_add(unsigned* p, unsigned v) { return __hip_atomic_fetch_add(p, v, __ATOMIC_RELAXED, __HIP_MEMORY_SCOPE_AGENT); }
__device__ __forceinline__ unsigned xb_xcc_id() { return (unsigned)__builtin_amdgcn_s_getreg((3 << 11) | 20) & 0xFu; }
#define XB_SPIN(cond, bar) do { unsigned _sp = 0; while (cond) { __builtin_amdgcn_s_sleep(1); \
    if ((++_sp & 255u) == 0u) { if (xb_ld(&(bar)[XB_TMO])) break; if (_sp > XB_SPIN_CAP) { atomicAdd(&(bar)[XB_TMO], 1u); break; } } } } while (0)
__device__ __forceinline__ void xcd_barrier_complete(unsigned* bar, unsigned x, unsigned G, unsigned& nloc, unsigned& nx) {
    unsigned sum, cnt, mine, sp = 0u;
    for (;;) {
        sum = 0u; cnt = 0u; mine = 0u;
#pragma unroll
        for (unsigned j = 0; j < 16; ++j) { const unsigned c = xb_ld(&bar[XB_XCNT(j)]); sum += c; cnt += (c > 0u) ? 1u : 0u; mine = (j == x) ? c : mine; }
        if (sum == G) break;
        __builtin_amdgcn_s_sleep(1);
        if ((++sp & 255u) == 0u) { if (xb_ld(&bar[XB_TMO])) break; if (sp > XB_SPIN_CAP) { atomicAdd(&bar[XB_TMO], 1u); break; } }
    }
    nloc = mine > 0u ? mine : 1u; nx = cnt > 0u ? cnt : 1u;
}
__device__ __forceinline__ void xcd_barrier(unsigned* bar, volatile LAS unsigned* st, bool leader, unsigned total) {
    asm volatile("s_waitcnt vmcnt(0)" ::: "memory");
    __syncthreads();
    if (leader) {
        __builtin_amdgcn_s_waitcnt(0);
        const unsigned x = xb_xcc_id();
        unsigned nloc = st[0], nx = st[1];
        if (nloc == 0u) { xcd_barrier_complete(bar, x, total, nloc, nx); st[0] = nloc; st[1] = nx; }
        const unsigned old = xb_add(&bar[XB_XSUB(x)], 1u);
        const unsigned gen = old / nloc;
        if (old + 1u == (gen + 1u) * nloc) {
            __builtin_amdgcn_fence(__ATOMIC_RELEASE, "agent");
            asm volatile("s_waitcnt vmcnt(0)" ::: "memory");
            if (nx > 1u) {
                const unsigned og = xb_add(&bar[XB_TOP], 1u);
                const unsigned tg = og / nx;
                if (og + 1u == (tg + 1u) * nx) xb_add(&bar[XB_TOPGEN], 1u);
                else XB_SPIN(xb_ld(&bar[XB_TOPGEN]) == tg, bar);
            }
            xb_add(&bar[XB_XGEN(x)], 1u);
            __builtin_amdgcn_fence(__ATOMIC_ACQUIRE, "agent");
            asm volatile("s_waitcnt vmcnt(0)" ::: "memory");
        } else {
            XB_SPIN(xb_ld(&bar[XB_XGEN(x)]) == gen, bar);
            __builtin_amdgcn_fence(__ATOMIC_ACQUIRE, "agent");
            asm volatile("s_waitcnt vmcnt(0)" ::: "memory");
        }
    }
    __syncthreads();
}
#ifndef PH3_SUB
#define PH3_SUB 3
#endif
__global__ void __launch_bounds__(NTHREADS, 2) fwd_megakernel(Args a) {
    extern __shared__ __attribute__((aligned(16))) unsigned char lds_[];
    cg::grid_group grid = cg::this_grid();
    LAS unsigned char* ldsl = (LAS unsigned char*)lds_;
    char* lds = (char*)lds_;
    const int wave0 = __builtin_amdgcn_readfirstlane((int)threadIdx.x >> 6);
    const int G = gridDim.x, bx = blockIdx.x;
    const int vcu = (G % 8 == 0) ? (bx % 8) * (G / 8) + bx / 8 : bx;
#ifndef PH_MASK
#define PH_MASK 0x1fffff
#endif
#define IN(k) ((PH_MASK >> (k)) & 1)
#ifndef DUP_PHASE
#define DUP_PHASE -1
#endif
#ifndef DUP3_SUB
#define DUP3_SUB 3
#endif
#define REPS(k) ((k) == DUP_PHASE ? 2 : 1)
    volatile LAS unsigned* bst = (volatile LAS unsigned*)(ldsl + LDS_BYTES - 64);
    const bool leader = (wave0 == 0) && (lane_id() == 0);
    if (leader) { bst[0] = 0u; bst[1] = 0u; bst[2] = 0u; bst[3] = 0u; const unsigned x_ = xb_xcc_id();
        (void)xb_add((unsigned*)arg_ws() + XB_XCNT(x_), 1u); (void)xb_add((unsigned*)arg_ws() + 4096 * (1 + (bx & 7)) + XB_XCNT(x_), 1u); }
    __syncthreads();
    if (a.ph_lo == 0x7fffffff) grid.sync();
#define LOCAL_SEAM(k) do { if (IN(k) && IN((k) + 1)) { asm volatile("s_waitcnt vmcnt(0)" ::: "memory"); __syncthreads(); \
        if (wave0 == 0) { __builtin_amdgcn_fence(__ATOMIC_ACQUIRE, "agent"); asm volatile("s_waitcnt vmcnt(0)" ::: "memory"); } __syncthreads(); } } while (0)
#define SYNC(k) do { if (IN(k) && IN((k) + 1)) xcd_barrier((unsigned*)arg_ws(), bst, (wave0 == 0) && (lane_id() == 0), (unsigned)G); } while (0)
#define GSYNC(k) do { if (IN(k) && IN((k) + 1)) { if (G == 256) xcd_barrier((unsigned*)arg_ws() + 4096 * (1 + (bx & 7)), bst + 2, (wave0 == 0) && (lane_id() == 0), 32u); \
        else xcd_barrier((unsigned*)arg_ws(), bst, (wave0 == 0) && (lane_id() == 0), (unsigned)G); } } while (0)
#define WSP(name, T, off) T* name = (T*)(wsp + (off))
#define GSLAB(mib) ((G == 256) ? (size_t)(bx & 7) * (mib) * MiB : (size_t)0)
    if (IN(0)) for (int rep_ = 0; rep_ < REPS(0); ++rep_) phase_prologue(lds, wave0);
    SYNC(0);
    if (IN(1)) for (int rep_ = 0; rep_ < REPS(1); ++rep_) {
        unsigned char* wsp = arg_ws();
        WSP(RSS, float, WS_RSS); WSP(LSS, float, WS_LSS); WSP(XB, bf16_t, WS_XB); WSP(HYT, bf16_t, WS_HYT); WSP(LAT, bf16_t, WS_LAT); WSP(KM, bf16_t, WS_KM); WSP(MEMK, bf16_t, WS_MEMK); WSP(VT, bf16_t, WS_VT);
        run_gemm(ldsl, wave0, XB, DM, (const bf16_t*)(wsp + WS_W_IN), DM, T_TOK, 2048, DM, EpiIn{RSS, HYT, LAT, LSS, KM});
        run_gemm(ldsl, wave0, (const bf16_t*)(wsp + WS_MEMN), DM, (const bf16_t*)(wsp + WS_W_XKV), DM, NB * NMEM, 4096, DM, EpiMemKV{MEMK, VT});
    }
    GSYNC(1);
    if (IN(2)) for (int rep_ = 0; rep_ < REPS(2); ++rep_) {
        unsigned char* wsp = arg_ws();
        WSP(LSS, float, WS_LSS); WSP(LAT, bf16_t, WS_LAT); WSP(QM, bf16_t, WS_QM); WSP(KM, bf16_t, WS_KM); WSP(VM, bf16_t, WS_VM);
        run_gemm(ldsl, wave0, LAT, 384, (const bf16_t*)(wsp + WS_W_UQ), 256, T_TOK, 768, 256, EpiUq{LSS, QM});
        run_gemm(ldsl, wave0, LAT + 128, 384, (const bf16_t*)(wsp + WS_W_UKV), 256, T_TOK, 1024, 256, EpiUkv{LSS, KM, VM});
    }
    SYNC(2);
    if (IN(3)) for (int rep_ = 0; rep_ < REPS(3); ++rep_) {
        unsigned char* wsp = arg_ws();
        WSP(ACT1, bf16_t, WS_ACT1); WSP(HYT, bf16_t, WS_HYT); WSP(QM, bf16_t, WS_QM); WSP(KM, bf16_t, WS_KM); WSP(VM, bf16_t, WS_VM);
        unsigned* hcnt = (unsigned*)wsp + 3584 + 64 * rep_;
        if ((PH3_SUB & 1) && (rep_ == 0 || (DUP3_SUB & 1))) for (int c = vcu; c < 512; c += G) hyena_unit(lds, wave0, c, HYT, (const bf16_t*)(wsp + WS_FILT), arg_in(3), arg_in(4), arg_in(11), HYT);
        asm volatile("s_waitcnt vmcnt(0)" ::: "memory"); __syncthreads();
        if (wave0 == 0 && lane_id() == 0) { __builtin_amdgcn_fence(__ATOMIC_RELEASE, "agent"); asm volatile("s_waitcnt vmcnt(0)" ::: "memory"); (void)xb_add(hcnt, 1u); }
        const int upc = (1024 + G - 1) / G;
        if ((PH3_SUB & 2) && (rep_ == 0 || (DUP3_SUB & 2))) for (int r_ = 0; r_ < 4 && G == 256; ++r_) {
            const int xc = vcu >> 5, cc = vcu & 31, bh = xc * 16 + r_ * 4 + (cc >> 3), qb = cc & 7, b = bh >> 3, h = bh & 7;
            const size_t row0 = (size_t)b * SEQ + qb * 256;
            AttnIO io{QM + row0 * 768 + h * 96, 768, KM + (size_t)b * SEQ * 768 + h * 96, 768, VM + (size_t)b * SEQ * 512 + h * 64, 512, ACT1 + row0 * DM + 512 + h * 64, DM, 0.f};
            attn_unit_d<0>(lds, wave0, io);
        }
        if (wave0 == 0 && lane_id() == 0) { unsigned sp = 0; while (xb_ld(hcnt) < (unsigned)G) { __builtin_amdgcn_s_sleep(2); if (++sp > (1u << 24)) break; }
            __builtin_amdgcn_fence(__ATOMIC_ACQUIRE, "agent"); asm volatile("s_waitcnt vmcnt(0)" ::: "memory"); }
        __syncthreads();
        {
            const int lane = lane_id();
            bf16_t* tl = (bf16_t*)(lds + wave0 * 16384);
            for (int it = bx * NWAVES + wave0; it < 512 * 8; it += G * NWAVES) {
                const int t0 = (it >> 3) * 64, c0 = (it & 7) * 64;
#pragma unroll
                for (int k = 0; k < 8; ++k) { const int cc = 8 * k + (lane >> 3), ch = lane & 7;
                    *(u32x4*)(tl + cc * 72 + ch * 8) = *(const u32x4*)(HYT + (size_t)(c0 + cc) * T_TOK + t0 + ch * 8); }
                asm volatile("s_waitcnt lgkmcnt(0)" ::: "memory");
#pragma unroll
                for (int k = 0; k < 8; ++k) { const int tt = 8 * k + (lane >> 3), ch = lane & 7;
                    unsigned short e[8];
#pragma unroll
                    for (int j = 0; j < 8; ++j) e[j] = tl[(ch * 8 + j) * 72 + tt];
                    u32x4 w; w.x = e[0] | ((unsigned)e[1] << 16); w.y = e[2] | ((unsigned)e[3] << 16); w.z = e[4] | ((unsigned)e[5] << 16); w.w = e[6] | ((unsigned)e[7] << 16);
                    *(u32x4*)(ACT1 + (size_t)(t0 + tt) * DM + c0 + ch * 8) = w; }
                asm volatile("s_waitcnt lgkmcnt(0)" ::: "memory");
            }
        }
    }
    SYNC(3);
    if (G == 256 && (bx & 1)) { __builtin_amdgcn_s_sleep(127); __builtin_amdgcn_s_sleep(127); }
    if (IN(4)) for (int rep_ = 0; rep_ < REPS(4); ++rep_) {
        unsigned char* wsp = arg_ws();
        WSP(RSS, float, WS_RSS); WSP(XB, bf16_t, WS_XB); WSP(ACT1, bf16_t, WS_ACT1);
        run_gemm(ldsl, wave0, ACT1, DM, (const bf16_t*)(wsp + WS_W_OUT0), DM, T_TOK, DM, DM, EpiRes{XB, (REPS(4) == 2 && rep_ == 0) ? (bf16_t*)(wsp + WS_BIG + 96 * MiB) : XB, (REPS(4) == 2 && rep_ == 0) ? (float*)(wsp + 5 * MiB) : RSS});
    }
    GSYNC(4);
    for (int l = 0; l < 2; ++l) {
        if (l == 1) {
            if (IN(11)) for (int rep_ = 0; rep_ < REPS(11); ++rep_) {
                unsigned char* wsp = arg_ws();
                WSP(RSS, float, WS_RSS); WSP(XB, bf16_t, WS_XB); WSP(QKV, bf16_t, WS_QKV + GSLAB(8));
                run_gemm(ldsl, wave0, XB, DM, (const bf16_t*)(wsp + WS_W_QKV), DM, T_TOK, 3072, DM, EpiQkv{RSS, QKV});
            }
            GSYNC(11);
            if (IN(12)) for (int rep_ = 0; rep_ < REPS(12); ++rep_) {
                unsigned char* wsp = arg_ws();
                WSP(ACT1, bf16_t, WS_ACT1); WSP(QKV, bf16_t, WS_QKV + GSLAB(8));
                float d1 = 0.f, d2 = 0.f;
                { const float* q1 = arg_in(18); const float* k1 = arg_in(19); const float* q2 = arg_in(20); const float* k2 = arg_in(21);
                  for (int k = 0; k < 64; ++k) { d1 += q1[k] * k1[k]; d2 += q2[k] * k2[k]; } }
                const float lam = expf(d1) - expf(d2) + LAM_INIT;
                const int upc = (2048 + G - 1) / G;
                for (int r_ = 0; r_ < 8 && G == 256; ++r_) {
                    const int xc = vcu >> 5, cc = vcu & 31, bh = xc * 16 + r_ * 2 + (cc >> 4), rt = cc & 15, b = bh >> 3, h = bh & 7;
                    const size_t row0 = (size_t)b * SEQ + rt * 128;
                    AttnIO io{QKV + row0 * 3072 + h * 128, 3072, QKV + (size_t)b * SEQ * 3072 + 1024 + h * 128, 3072, QKV + (size_t)b * SEQ * 3072 + 2048 + h * 128, 3072, ACT1 + row0 * DM + h * 128, DM, lam};
                    attn_unit_d<1>(lds, wave0, io);
                }
            }
            GSYNC(12);
            if (IN(13)) for (int rep_ = 0; rep_ < REPS(13); ++rep_) {
                unsigned char* wsp = arg_ws();
                WSP(RSS, float, WS_RSS); WSP(XB, bf16_t, WS_XB); WSP(ACT1, bf16_t, WS_ACT1);
                run_gemm(ldsl, wave0, ACT1, DM, (const bf16_t*)(wsp + WS_W_OUT1), DM, T_TOK, DM, DM, EpiRes{XB, (REPS(13) == 2 && rep_ == 0) ? (bf16_t*)(wsp + WS_BIG + 192 * MiB) : XB, (REPS(13) == 2 && rep_ == 0) ? (float*)(wsp + 5 * MiB) : RSS});
            }
            GSYNC(13);
        }
        const int p_xq = l == 0 ? 5 : 14;
        if (IN(p_xq)) for (int rep_ = 0; rep_ < REPS(p_xq); ++rep_) {
            unsigned char* wsp = arg_ws();
            WSP(RSS, float, WS_RSS); WSP(XB, bf16_t, WS_XB); WSP(ACT1, bf16_t, WS_ACT1);
            run_gemm(ldsl, wave0, XB, DM, (const bf16_t*)(wsp + WS_W_XQ) + (size_t)l * DM * DM, DM, T_TOK, DM, DM, EpiNormBf16{RSS, ACT1, DM, 0.0625f * LOG2E});
        }
        LOCAL_SEAM(p_xq);
        if (IN(p_xq + 1)) for (int rep_ = 0; rep_ < REPS(p_xq + 1); ++rep_) {
            unsigned char* wsp = arg_ws();
            WSP(ACT1, bf16_t, WS_ACT1); WSP(MEMK, bf16_t, WS_MEMK); WSP(PBUF, bf16_t, WS_PBUF + GSLAB(24));
            run_gemm_ad(ldsl, wave0, DM, 2048, T_TOK, DM, 256, pg8::EpiSoftmax{PBUF, DM}, AddrXS{(const char*)ACT1, (const char*)(MEMK + l * 1024)});
        }
        LOCAL_SEAM(p_xq + 1);
        if (IN(p_xq + 2)) for (int rep_ = 0; rep_ < REPS(p_xq + 2); ++rep_) {
            unsigned char* wsp = arg_ws();
            WSP(ACT1, bf16_t, WS_ACT1); WSP(VT, bf16_t, WS_VT); WSP(PBUF, bf16_t, WS_PBUF + GSLAB(24));
            run_gemm_ad(ldsl, wave0, DM, 256, T_TOK, DM, 256, pg8::Epi8<EpiPlain>{EpiPlain{ACT1, DM}}, AddrXV{(const char*)PBUF, (const char*)(VT + (size_t)l * NB * 1024 * 256)});
        }
        GSYNC(p_xq + 2);
        if (IN(p_xq + 3)) for (int rep_ = 0; rep_ < REPS(p_xq + 3); ++rep_) {
            unsigned char* wsp = arg_ws();
            WSP(RSS, float, WS_RSS); WSP(XB, bf16_t, WS_XB); WSP(ACT1, bf16_t, WS_ACT1);
            run_gemm(ldsl, wave0, ACT1, DM, (const bf16_t*)(wsp + WS_W_XO) + (size_t)l * DM * DM, DM, T_TOK, DM, DM, EpiRes{XB, (REPS(p_xq + 3) == 2 && rep_ == 0) ? (bf16_t*)(wsp + WS_BIG + 64 * MiB) : XB, (REPS(p_xq + 3) == 2 && rep_ == 0) ? (float*)(wsp + 5 * MiB) : RSS});
        }
        GSYNC(p_xq + 3);
        if (IN(p_xq + 4)) for (int rep_ = 0; rep_ < REPS(p_xq + 4); ++rep_) {
            unsigned char* wsp = arg_ws();
            WSP(RSS, float, WS_RSS); WSP(XB, bf16_t, WS_XB); WSP(HMID, bf16_t, WS_HMID);
            run_gemm(ldsl, wave0, XB, DM, (const bf16_t*)(wsp + WS_W_UP) + (size_t)l * DFF * DM, DM, T_TOK, DFF, DM, EpiUp{RSS, HMID});
        }
        GSYNC(p_xq + 4);
        if (IN(p_xq + 5)) for (int rep_ = 0; rep_ < REPS(p_xq + 5); ++rep_) {
            unsigned char* wsp = arg_ws();
            WSP(RSS, float, WS_RSS); WSP(XB, bf16_t, WS_XB); WSP(HMID, bf16_t, WS_HMID);
            run_gemm(ldsl, wave0, HMID, DFF, (const bf16_t*)(wsp + WS_W_DN) + (size_t)l * DM * DFF, DFF, T_TOK, DM, DFF, EpiRes{XB, (REPS(p_xq + 5) == 2 && rep_ == 0) ? (bf16_t*)(wsp + WS_ACT1) : XB, (REPS(p_xq + 5) == 2 && rep_ == 0) ? (float*)(wsp + 5 * MiB) : RSS});
        }
        GSYNC(p_xq + 5);
    }
    if (IN(20)) for (int rep_ = 0; rep_ < REPS(20); ++rep_) {
        const int lane = lane_id(), wave = wave0;
        const float* gfin = arg_in(33); float* outp = arg_out(); const bf16_t* XB = (const bf16_t*)(arg_ws() + WS_XB);
        const int g0_ = (G == 256) ? (bx & 7) * (T_TOK / 8) + (bx >> 3) * NWAVES : bx * NWAVES, g1_ = (G == 256) ? ((bx & 7) + 1) * (T_TOK / 8) : T_TOK, gs_ = (G == 256) ? 32 * NWAVES : G * NWAVES;
        for (int row = g0_ + wave; row < g1_; row += gs_) {
            const u32x4 a0 = *(const u32x4*)(XB + (size_t)row * DM + 8 * lane), a1 = *(const u32x4*)(XB + (size_t)row * DM + 512 + 8 * lane);
            float v[16];
            v[0] = __builtin_bit_cast(float, a0.x << 16); v[1] = __builtin_bit_cast(float, a0.x & 0xffff0000u); v[2] = __builtin_bit_cast(float, a0.y << 16); v[3] = __builtin_bit_cast(float, a0.y & 0xffff0000u);
            v[4] = __builtin_bit_cast(float, a0.z << 16); v[5] = __builtin_bit_cast(float, a0.z & 0xffff0000u); v[6] = __builtin_bit_cast(float, a0.w << 16); v[7] = __builtin_bit_cast(float, a0.w & 0xffff0000u);
            v[8] = __builtin_bit_cast(float, a1.x << 16); v[9] = __builtin_bit_cast(float, a1.x & 0xffff0000u); v[10] = __builtin_bit_cast(float, a1.y << 16); v[11] = __builtin_bit_cast(float, a1.y & 0xffff0000u);
            v[12] = __builtin_bit_cast(float, a1.z << 16); v[13] = __builtin_bit_cast(float, a1.z & 0xffff0000u); v[14] = __builtin_bit_cast(float, a1.w << 16); v[15] = __builtin_bit_cast(float, a1.w & 0xffff0000u);
            float s = 0.f;
#pragma unroll
            for (int j = 0; j < 16; ++j) s += v[j] * v[j];
            s = wave_sum(s);
            const float rn = 1.0f / sqrtf(s * (1.0f / DM) + EPS);
            float* p = outp + (size_t)row * DM;
#pragma unroll
            for (int h = 0; h < 2; ++h)
#pragma unroll
                for (int q = 0; q < 2; ++q) { const int c = 512 * h + 8 * lane + 4 * q; const f32x4 gg = *(const f32x4*)(gfin + c);
                    *(f32x4*)(p + c) = (f32x4){v[8 * h + 4 * q] * rn * gg.x, v[8 * h + 4 * q + 1] * rn * gg.y, v[8 * h + 4 * q + 2] * rn * gg.z, v[8 * h + 4 * q + 3] * rn * gg.w}; }
        }
    }
#undef IN
#undef SYNC
#undef GSYNC
}

extern "C" void kernel_launch(void* const* d_in, const int* in_sizes, int n_in, void* d_out, int out_size,
                              void* d_ws, size_t ws_size, hipStream_t stream) {
    static int grid = 0;
    if (grid == 0) {
        if (n_in != 34 || out_size != T_TOK * DM || ws_size < WS_END) { fprintf(stderr, "kernel_launch: unexpected shapes n_in %d out %d ws %zu (need %zu)\n", n_in, out_size, ws_size, (size_t)WS_END); grid = -1; return; }
        int dev = 0, cus = 0, per_cu = 0;
        (void)hipGetDevice(&dev);
        (void)hipDeviceGetAttribute(&cus, hipDeviceAttributeMultiprocessorCount, dev);
        (void)hipFuncSetAttribute((const void*)fwd_megakernel, hipFuncAttributeMaxDynamicSharedMemorySize, LDS_BYTES);
        (void)hipOccupancyMaxActiveBlocksPerMultiprocessor(&per_cu, (const void*)fwd_megakernel, NTHREADS, LDS_BYTES);
        if (per_cu < 1) { fprintf(stderr, "kernel_launch: occupancy query reports %d blocks per CU\n", per_cu); }
        grid = cus;
        if (cus != 256) fprintf(stderr, "kernel_launch: built for a 256-CU device (attention unit maps assume 256 workgroups); this device reports %d CUs\n", cus);
    }
    if (grid < 0) return;
    (void)hipMemsetAsync(d_ws, 0, 9 * 16384, stream);
    Args a{};
    for (int i = 0; i < 34; ++i) a.in[i] = (const float*)d_in[i];
    a.out = (float*)d_out; a.ws = (unsigned char*)d_ws; a.ph_lo = 0; a.ph_hi = 21;
    void* args[] = {&a};
    hipError_t e = hipLaunchCooperativeKernel((const void*)fwd_megakernel, dim3(grid), dim3(NTHREADS), args, LDS_BYTES, stream);
    if (e != hipSuccess) fprintf(stderr, "cooperative launch failed: %s (grid %d)\n", hipGetErrorString(e), grid);
}
```
